# Optimizing an MI355X kernel written in HIP

```python
import jax, jax.numpy as jnp
from jax import lax
import numpy as np

D_MODEL = 1024
BATCH = 32
SEQ = 2048
DEPTH = 2

GRID_W = 64
ATTN_HEADS = 16
ATTN_KV_HEADS = 4
ATTN_HEAD_DIM = 64
ATTN_GROUP = ATTN_HEADS // ATTN_KV_HEADS
ATTN_WIDTH = ATTN_HEADS * ATTN_HEAD_DIM
ATTN_KV_WIDTH = ATTN_KV_HEADS * ATTN_HEAD_DIM
ROPE_AXIS_DIM = ATTN_HEAD_DIM // 2
ROPE_THETA = 10000.0
Q_BLOCK = 128
HGRN_EXPAND = 128
HGRN_HEADS = D_MODEL // HGRN_EXPAND
HGRN_HEAD_V = 128
HGRN_KEY_WIDTH = HGRN_HEADS * HGRN_EXPAND
HGRN_VAL_WIDTH = HGRN_HEADS * HGRN_HEAD_V
HGRN_CHUNK = 32
N_DIRECTIONS = 2
NORM_EPS = 1e-6

SPLIT_SIZES = (ATTN_WIDTH, ATTN_KV_WIDTH, ATTN_KV_WIDTH, ATTN_WIDTH,
               HGRN_KEY_WIDTH, HGRN_KEY_WIDTH, HGRN_KEY_WIDTH, HGRN_VAL_WIDTH, HGRN_VAL_WIDTH,
               D_MODEL, D_MODEL)
N_IN = sum(SPLIT_SIZES)

kernel_name = "hybrid_gqa_axialrope_hgrn2_bidir"


def _split_indices():
    return [int(i) for i in np.cumsum(SPLIT_SIZES)[:-1]]


def _rms_norm(x, w):
    xf = x.astype(jnp.float32)
    y = xf * lax.rsqrt(jnp.mean(xf * xf, axis=-1, keepdims=True) + NORM_EPS)
    return (y * w.astype(jnp.float32)).astype(x.dtype)


def _axial_rope(seq_len):
    rows = seq_len // GRID_W
    row = jnp.repeat(jnp.arange(rows), GRID_W).astype(jnp.float32)
    col = jnp.tile(jnp.arange(GRID_W), rows).astype(jnp.float32)
    inv_freq = ROPE_THETA ** (-jnp.arange(0, ROPE_AXIS_DIM, 2, dtype=jnp.float32) / ROPE_AXIS_DIM)
    ang_r = row[:, None] * inv_freq
    ang_c = col[:, None] * inv_freq
    return jnp.cos(ang_r), jnp.sin(ang_r), jnp.cos(ang_c), jnp.sin(ang_c)


def _rotate(seg, c, s):
    half = seg.shape[-1] // 2
    x1, x2 = seg[..., :half], seg[..., half:]
    return jnp.concatenate([x1 * c - x2 * s, x2 * c + x1 * s], axis=-1)


def _apply_axial_rope(x, rope):
    cr, sr, cc, sc = [t[None, :, None, :] for t in rope]
    xf = x.astype(jnp.float32)
    out = jnp.concatenate([_rotate(xf[..., :ROPE_AXIS_DIM], cr, sr),
                           _rotate(xf[..., ROPE_AXIS_DIM:], cc, sc)], axis=-1)
    return out.astype(x.dtype)


def _blocked_attention(q, k, v):
    B, S, _, hd = q.shape
    nb = S // Q_BLOCK
    qb = q.reshape(B, nb, Q_BLOCK, ATTN_KV_HEADS, ATTN_GROUP, hd).transpose(1, 0, 3, 4, 2, 5)
    kt = k.transpose(0, 2, 1, 3)
    vt = v.transpose(0, 2, 1, 3)
    scale = hd ** -0.5

    def one_block(q_blk):
        s = jnp.einsum('bkgqd,bksd->bkgqs', q_blk, kt).astype(jnp.float32) * scale
        p = jax.nn.softmax(s, axis=-1).astype(vt.dtype)
        return jnp.einsum('bkgqs,bksd->bkgqd', p, vt)

    o = lax.map(one_block, qb)
    return o.transpose(1, 0, 4, 2, 3, 5).reshape(B, S, ATTN_WIDTH)


def _attention_branch(aq, ak, av, q_norm_w, k_norm_w, rope):
    B, S, _ = aq.shape
    q = aq.reshape(B, S, ATTN_HEADS, ATTN_HEAD_DIM)
    k = ak.reshape(B, S, ATTN_KV_HEADS, ATTN_HEAD_DIM)
    v = av.reshape(B, S, ATTN_KV_HEADS, ATTN_HEAD_DIM)
    q = _apply_axial_rope(_rms_norm(q, q_norm_w), rope)
    k = _apply_axial_rope(_rms_norm(k, k_norm_w), rope)
    return _blocked_attention(q, k, v)


def _hgrn2_chunk_scan(q, k, v, log_f):
    B, H, S, DK = q.shape
    DV = v.shape[-1]
    n = S // HGRN_CHUNK

    def to_chunks(a):
        return a.reshape(B, H, n, HGRN_CHUNK, a.shape[-1]).transpose(2, 0, 1, 3, 4)

    mask = jnp.tril(jnp.ones((HGRN_CHUNK, HGRN_CHUNK), dtype=bool))[None, None, :, :, None]

    def step(state, inp):
        q_c, k_c, v_c, g_c = inp
        b = jnp.cumsum(g_c, axis=2)
        diff = b[:, :, :, None, :] - b[:, :, None, :, :]
        decay = jnp.exp(jnp.where(mask, diff, -jnp.inf))
        scores = jnp.einsum('bhtk,bhsk,bhtsk->bhts', q_c, k_c, decay)
        o = jnp.einsum('bhts,bhsv->bhtv', scores, v_c) \
            + jnp.einsum('bhtk,bhkv->bhtv', q_c * jnp.exp(b), state)
        b_last = b[:, :, -1:, :]
        state = jnp.exp(b_last[:, :, 0, :])[..., None] * state \
            + jnp.einsum('bhsk,bhsv->bhkv', k_c * jnp.exp(b_last - b), v_c)
        return state, o

    state0 = jnp.zeros((B, H, DK, DV), jnp.float32)
    _, o = lax.scan(step, state0, (to_chunks(q), to_chunks(k), to_chunks(v), to_chunks(log_f)))
    return o.transpose(1, 2, 0, 3, 4).reshape(B, H, S, DV)


def _hgrn2_branch(hq, hf_fwd, hf_bwd, hi, lb_layer, g_norm_w):
    B, S, _ = hq.shape

    def heads(a, d):
        return a.reshape(B, S, HGRN_HEADS, d).transpose(0, 2, 1, 3).astype(jnp.float32)

    q = jax.nn.silu(heads(hq, HGRN_EXPAND)) * (HGRN_EXPAND ** -0.5)
    v = heads(hi, HGRN_HEAD_V)

    def direction(z_raw, lb, backward):
        z = heads(z_raw, HGRN_EXPAND)
        lb = lb.reshape(1, HGRN_HEADS, 1, HGRN_EXPAND)
        log_f = jnp.logaddexp(jnp.log(lb), jnp.log1p(-lb) + jax.nn.log_sigmoid(z))
        k = -jnp.expm1(log_f)
        if backward:
            o = _hgrn2_chunk_scan(q[:, :, ::-1], k[:, :, ::-1], v[:, :, ::-1], log_f[:, :, ::-1])
            return o[:, :, ::-1]
        return _hgrn2_chunk_scan(q, k, v, log_f)

    o = direction(hf_fwd, lb_layer[0], False) + direction(hf_bwd, lb_layer[1], True)
    o = _rms_norm(o, g_norm_w)
    return o.transpose(0, 2, 1, 3).reshape(B, S, HGRN_VAL_WIDTH).astype(hq.dtype)


def setup_inputs(seed: int = 0) -> dict:
    key = jax.random.key(seed)
    ks = jax.random.split(key, 12)
    f32 = jnp.float32
    x = jax.random.normal(ks[0], (BATCH, SEQ, D_MODEL), f32)
    w_in = jax.random.normal(ks[1], (DEPTH, D_MODEL, N_IN), f32) * D_MODEL ** -0.5
    norm_w = 1.0 + 0.02 * jax.random.normal(ks[2], (DEPTH, D_MODEL), f32)
    q_norm_w = 1.0 + 0.02 * jax.random.normal(ks[3], (DEPTH, ATTN_HEAD_DIM), f32)
    k_norm_w = 1.0 + 0.02 * jax.random.normal(ks[4], (DEPTH, ATTN_HEAD_DIM), f32)
    hgrn_lower_bounds = 0.1 * jax.random.normal(ks[5], (N_DIRECTIONS, DEPTH, HGRN_KEY_WIDTH), f32)
    hgrn_norm_w = 1.0 + 0.02 * jax.random.normal(ks[6], (DEPTH, HGRN_HEAD_V), f32)
    w_branch_attn = jax.random.normal(ks[7], (DEPTH, ATTN_WIDTH, D_MODEL), f32) * ATTN_WIDTH ** -0.5
    w_branch_hgrn = jax.random.normal(ks[8], (DEPTH, HGRN_VAL_WIDTH, D_MODEL), f32) * HGRN_VAL_WIDTH ** -0.5
    w_out = jax.random.normal(ks[9], (DEPTH, D_MODEL, D_MODEL), f32) * D_MODEL ** -0.5
    final_norm_w = 1.0 + 0.02 * jax.random.normal(ks[10], (D_MODEL,), f32)
    return {"x": x, "w_in": w_in, "norm_w": norm_w, "q_norm_w": q_norm_w, "k_norm_w": k_norm_w,
            "hgrn_lower_bounds": hgrn_lower_bounds, "hgrn_norm_w": hgrn_norm_w,
            "w_branch_attn": w_branch_attn, "w_branch_hgrn": w_branch_hgrn, "w_out": w_out,
            "final_norm_w": final_norm_w}


def reference(x, w_in, norm_w, q_norm_w, k_norm_w, hgrn_lower_bounds, hgrn_norm_w,
              w_branch_attn, w_branch_hgrn, w_out, final_norm_w):
    S = x.shape[1]
    rope = _axial_rope(S)
    lb = jnp.cumsum(jax.nn.softmax(hgrn_lower_bounds.astype(jnp.float32), axis=1), axis=1)
    lb = lb - lb[:, :1]
    split_at = _split_indices()
    for layer in range(DEPTH):
        h = _rms_norm(x, norm_w[layer])
        proj = jnp.einsum('bsd,de->bse', h, w_in[layer])
        (aq, ak, av, a_gate, hq, hf_fwd, hf_bwd, hi, h_gate, m_attn, m_hgrn) = jnp.split(proj, split_at, axis=-1)
        y_attn = _attention_branch(aq, ak, av, q_norm_w[layer], k_norm_w[layer], rope) * jax.nn.silu(a_gate)
        y_hgrn = _hgrn2_branch(hq, hf_fwd, hf_bwd, hi, lb[:, layer], hgrn_norm_w[layer]) * jax.nn.silu(h_gate)
        merged = jax.nn.sigmoid(m_attn) * jnp.einsum('bse,ed->bsd', y_attn, w_branch_attn[layer]) \
            + jax.nn.sigmoid(m_hgrn) * jnp.einsum('bse,ed->bsd', y_hgrn, w_branch_hgrn[layer])
        x = x + jnp.einsum('bsd,de->bse', merged, w_out[layer])
    return _rms_norm(x, final_norm_w)
```

```cpp
#include <hip/hip_runtime.h>
#include <hip/hip_cooperative_groups.h>
#include <cstdio>
#include <cstdint>
namespace cg = cooperative_groups;

#define LAS __attribute__((address_space(3)))
typedef unsigned short bf16_t;
typedef short bf16x8 __attribute__((ext_vector_type(8)));
typedef short s16x4 __attribute__((ext_vector_type(4)));
typedef float f32x4 __attribute__((ext_vector_type(4)));
typedef float f32x16 __attribute__((ext_vector_type(16)));
typedef unsigned u32x4 __attribute__((ext_vector_type(4)));
typedef unsigned u32x2 __attribute__((ext_vector_type(2)));

constexpr int DM = 1024, SEQ = 2048, BATCH = 32, NTOK = BATCH * SEQ, NIN = 9728, DEPTH = 2;
constexpr int HB = 16, TH = HB * SEQ;
constexpr float EPS = 1e-6f;
constexpr int NTHREADS = 512;

constexpr size_t SZ_WIN = (size_t)NIN * DM * 2, SZ_W1 = (size_t)DM * DM * 2;
constexpr size_t WS_WIN = 0, WS_WA = WS_WIN + 2 * SZ_WIN, WS_WH = WS_WA + 2 * SZ_W1, WS_WO = WS_WH + 2 * SZ_W1;
constexpr size_t WS_XB = WS_WO + 2 * SZ_W1, WS_RROW = WS_XB + (size_t)NTOK * DM * 2, WS_TAB = WS_RROW + (size_t)NTOK * 4;
constexpr int TAB_COSR = 0, TAB_SINR = 512, TAB_COSC = 1024, TAB_SINC = 2048, TAB_LB = 3072, TAB_FLOATS = 3072 + 2 * 2 * 1024;
constexpr size_t WS_PROJ = (WS_TAB + TAB_FLOATS * 4 + 255) / 256 * 256;
constexpr size_t PO_Q = 0, PO_K = (size_t)TH * 1024, PO_V = (size_t)TH * 1280, PO_AG = (size_t)TH * 1536, PO_HQ = PO_AG + (size_t)TH * 1024,
                 PO_ZF = PO_HQ + (size_t)TH * 1024, PO_ZB = PO_ZF + (size_t)TH * 1024, PO_HI = PO_ZB + (size_t)TH * 1024, PO_HG = PO_HI + (size_t)TH * 1024,
                 PO_MA = PO_HG + (size_t)TH * 1024, PO_MH = PO_MA + (size_t)TH * 1024, PO_END = PO_MH + (size_t)TH * 1024;
constexpr size_t WS_END = WS_PROJ + PO_END * 2;

struct Params {
    const float* x; const float* w_in; const float* norm_w; const float* q_norm_w; const float* k_norm_w; const float* lbnd; const float* hnorm_w;
    const float* w_ba; const float* w_bh; const float* w_out; const float* fnorm_w; float* out; unsigned char* ws;
};

__device__ __forceinline__ unsigned cvt_pk_bf16(float lo, float hi) { unsigned r; asm volatile("v_cvt_pk_bf16_f32 %0, %1, %2" : "=v"(r) : "v"(lo), "v"(hi)); return r; }
__device__ __forceinline__ float bf2f(unsigned short v) { return __uint_as_float((unsigned)v << 16); }
__device__ __forceinline__ float bflo(unsigned w) { return __uint_as_float(w << 16); }
__device__ __forceinline__ float bfhi(unsigned w) { return __uint_as_float(w & 0xffff0000u); }
__device__ __forceinline__ unsigned pack_h2(float a, float b) { _Float16 ha = (_Float16)a, hb = (_Float16)b; return (unsigned)__builtin_bit_cast(unsigned short, ha) | ((unsigned)__builtin_bit_cast(unsigned short, hb) << 16); }
__device__ __forceinline__ float h2f(unsigned short v) { return (float)__builtin_bit_cast(_Float16, v); }
__device__ __forceinline__ float sigmoidf_(float x) { return 1.0f / (1.0f + __expf(-x)); }
__device__ __forceinline__ float siluf_(float x) { return x / (1.0f + __expf(-x)); }
#define LDS_BAR() do { asm volatile("s_waitcnt lgkmcnt(0)" ::: "memory"); __builtin_amdgcn_s_barrier(); asm volatile("" ::: "memory"); } while (0)

namespace pg8 {
constexpr int BM = 256, BK = 64, HALF = 128, HTB = HALF * BK * 2, STAGE_BYTES = 8 * HTB, NXCD = 8, WGM = 8;
__host__ __device__ __forceinline__ int lds_byte(int r, int c) { const int st = (r >> 4) * 2 + (c >> 5), rr = r & 15, cc = c & 31, ob = rr * 64 + cc * 2; return st * 1024 + (ob ^ (((ob >> 9) & 1) << 5)); }
__host__ __device__ __forceinline__ void stage_rc(int b, int& R, int& C) { const int st = b / 1024, sb = b % 1024, swz = sb ^ (((sb >> 9) & 1) << 5); R = (st >> 1) * 16 + swz / 64; C = (st & 1) * 32 + (swz % 64) / 2; }
__host__ __device__ __forceinline__ int perm32(int rho) { const int n = rho >> 4, i = rho & 15; return 8 * (i >> 2) + 4 * n + (i & 3); }

struct Unit { int pm, pn, z; };
struct Gemm { const bf16_t* A0; const bf16_t* B0; const bf16_t* A1; const bf16_t* B1; int M, N, K; };

struct StaticOrder {
    int nM, nN, nwg, G, c;
    __device__ void init(int M, int N, int G_, int c_) { nM = M / BM; nN = N / BM; nwg = nM * nN; G = G_; c = c_; }
    __device__ bool next(int i, Unit& u) const {
        const long L = (long)i * G + c; if (L >= nwg) return false;
        int wgid = (int)L; { const int q = nwg / NXCD, r = nwg % NXCD, xcd = wgid % NXCD, off = wgid / NXCD; wgid = (xcd < r ? xcd * (q + 1) : r * (q + 1) + (xcd - r) * q) + off; }
        const int nig = WGM * nN, gid = wgid / nig, fm = gid * WGM, gsz = (nM - fm) < WGM ? (nM - fm) : WGM;
        u.pm = fm + ((wgid % nig) % gsz); u.pn = (wgid % nig) / gsz; u.z = 0; return true;
    }
};
struct TwoPassOrder {
    StaticOrder S;
    __device__ bool next(int i, Unit& u) const { if (!S.next(i >> 1, u)) return false; u.z = i & 1; return true; }
};

template <class Epi, class Sched>
__device__ __forceinline__ void gemm_phase(LAS unsigned char* lds, const Gemm g, const Sched& S, const Epi& E) {
    int tid = threadIdx.x; asm volatile("" : "+v"(tid));
    const int wid = __builtin_amdgcn_readfirstlane(tid >> 6), lane = tid & 63, wr = wid >> 2, wc = wid & 3, fr = lane & 15, fq = lane >> 4;
    const int K = g.K, nt = K / BK;
    unsigned voffA[2], voffB[2];
#pragma unroll
    for (int i = 0; i < 2; ++i) { int R, C; stage_rc(tid * 16 + i * 8192, R, C); const int Rb = Epi::PERM ? ((R & ~31) + perm32(R & 31)) : R;
        voffA[i] = (unsigned)(R * K + C) * 2u; voffB[i] = (unsigned)(Rb * K + C) * 2u; }
    const size_t kstep = (size_t)(BK * 2);
    const size_t hstep = (size_t)HALF * K * 2;
    const size_t tstep = 2 * hstep;
    const unsigned ldsw = (unsigned)wid * 1024u;
    const int aoff = lds_byte(wr * 64 + fr, fq * 8), boff = lds_byte(wc * 32 + fr, fq * 8);
#define PG8_SA(b, h) (((b) * 2 + (h)) * HTB)
#define PG8_SB(b, h) ((4 + (b) * 2 + (h)) * HTB)
#define PG8_STAGE(bufoff, gbase, voff) do { _Pragma("unroll") for (int _i = 0; _i < 2; ++_i) \
        __builtin_amdgcn_global_load_lds((const unsigned*)((const char*)(gbase) + (voff)[_i]), (LAS unsigned*)(lds + (bufoff) + ldsw + _i * 8192), 16, 0, 0); } while (0)
#define PG8_LDA(dst, b, h) do { _Pragma("unroll") for (int m = 0; m < 4; ++m) _Pragma("unroll") for (int k = 0; k < 2; ++k) dst[m][k] = *(const LAS bf16x8*)(lds + PG8_SA(b, h) + aoff + m * 2048 + k * 1024); } while (0)
#define PG8_LDB(dst, b, h) do { _Pragma("unroll") for (int n = 0; n < 2; ++n) _Pragma("unroll") for (int k = 0; k < 2; ++k) dst[n][k] = *(const LAS bf16x8*)(lds + PG8_SB(b, h) + boff + n * 2048 + k * 1024); } while (0)
#define PG8_MMA(ai, bj, At, Bt) do { __builtin_amdgcn_s_setprio(1); _Pragma("unroll") for (int m = 0; m < 4; ++m) _Pragma("unroll") for (int n = 0; n < 2; ++n) _Pragma("unroll") for (int k = 0; k < 2; ++k) \
        acc[ai][bj][m][n] = __builtin_amdgcn_mfma_f32_16x16x32_bf16(Bt[n][k], At[m][k], acc[ai][bj][m][n], 0, 0, 0); __builtin_amdgcn_s_setprio(0); } while (0)
#define PG8_WAIT_V(n) asm volatile("s_waitcnt vmcnt(" #n ")" ::: "memory")
#define PG8_WAIT_L(n) asm volatile("s_waitcnt lgkmcnt(" #n ")" ::: "memory")
#define PG8_BAR __builtin_amdgcn_s_barrier()
#define PG8_SCHED __builtin_amdgcn_sched_barrier(0)
    Unit cur, nxt; int ui = 0;
    if (!S.next(0, cur)) return;
    f32x4 acc[2][2][4][2];
#pragma unroll
    for (int a = 0; a < 2; ++a)
#pragma unroll
        for (int b = 0; b < 2; ++b)
#pragma unroll
            for (int m = 0; m < 4; ++m)
#pragma unroll
                for (int n = 0; n < 2; ++n) acc[a][b][m][n] = (f32x4){0.f, 0.f, 0.f, 0.f};
    bf16x8 At[4][2], B0[2][2], B1[2][2];
    const char* cA = (const char*)(cur.z ? g.A1 : g.A0) + (size_t)cur.pm * tstep; const char* cB = (const char*)(cur.z ? g.B1 : g.B0) + (size_t)cur.pn * tstep;
    PG8_STAGE(PG8_SB(0, 0), cB, voffB); PG8_STAGE(PG8_SB(0, 1), cB + hstep, voffB); PG8_STAGE(PG8_SA(0, 0), cA, voffA); PG8_STAGE(PG8_SA(0, 1), cA + hstep, voffA);
    if (wr == 1) PG8_BAR;
    PG8_WAIT_V(2); PG8_BAR;
    PG8_STAGE(PG8_SB(1, 0), cB + kstep, voffB); PG8_STAGE(PG8_SA(1, 0), cA + kstep, voffA); PG8_STAGE(PG8_SB(1, 1), cB + hstep + kstep, voffB);
    PG8_WAIT_V(6); PG8_BAR;
    for (;;) {
        const bool has_next = S.next(ui + 1, nxt);
        const char* nA = has_next ? (const char*)(nxt.z ? g.A1 : g.A0) + (size_t)nxt.pm * tstep : cA; const char* nB = has_next ? (const char*)(nxt.z ? g.B1 : g.B0) + (size_t)nxt.pn * tstep : cB;
        for (int t = 0; t < nt; t += 2) {
            const bool last = (t == nt - 2);
            const char* a1 = cA + (size_t)(t + 1) * kstep;
            const char* a2 = last ? nA : cA + (size_t)(t + 2) * kstep; const char* b2 = last ? nB : cB + (size_t)(t + 2) * kstep;
            const char* a3 = a2 + kstep; const char* b3 = b2 + kstep;
            PG8_LDB(B0, 0, 0); PG8_LDB(B1, 0, 1); PG8_SCHED; PG8_LDA(At, 0, 0); PG8_STAGE(PG8_SA(1, 1), a1 + hstep, voffA);
            PG8_WAIT_V(8); PG8_WAIT_L(0); PG8_BAR; PG8_MMA(0, 0, At, B0); PG8_MMA(0, 1, At, B1); PG8_BAR; PG8_SCHED;
            PG8_LDA(At, 0, 1); PG8_STAGE(PG8_SB(0, 0), b2, voffB); PG8_STAGE(PG8_SB(0, 1), b2 + hstep, voffB); PG8_STAGE(PG8_SA(0, 0), a2, voffA);
            PG8_WAIT_V(8); PG8_WAIT_L(0); PG8_BAR; PG8_MMA(1, 0, At, B0); PG8_MMA(1, 1, At, B1); PG8_BAR; PG8_SCHED;
            PG8_LDB(B0, 1, 0); PG8_LDB(B1, 1, 1); PG8_SCHED; PG8_LDA(At, 1, 0); PG8_STAGE(PG8_SA(0, 1), a2 + hstep, voffA);
            PG8_WAIT_V(8); PG8_WAIT_L(0); PG8_BAR; PG8_MMA(0, 0, At, B0); PG8_MMA(0, 1, At, B1); PG8_BAR; PG8_SCHED;
            PG8_LDA(At, 1, 1); PG8_STAGE(PG8_SB(1, 0), b3, voffB); PG8_STAGE(PG8_SB(1, 1), b3 + hstep, voffB); PG8_STAGE(PG8_SA(1, 0), a3, voffA);
            PG8_WAIT_V(8); PG8_WAIT_L(0); PG8_BAR; PG8_MMA(1, 0, At, B0); PG8_MMA(1, 1, At, B1); PG8_BAR; PG8_SCHED;
        }
        if (wr == 0) PG8_BAR;
        E(acc, cur, wr, wc, fr, fq);
        if (!has_next) break;
#pragma unroll
        for (int a = 0; a < 2; ++a)
#pragma unroll
            for (int b = 0; b < 2; ++b)
#pragma unroll
                for (int m = 0; m < 4; ++m)
#pragma unroll
                    for (int n = 0; n < 2; ++n) acc[a][b][m][n] = (f32x4){0.f, 0.f, 0.f, 0.f};
        cur = nxt; cA = nA; cB = nB; ++ui;
        if (wr == 1) PG8_BAR;
    }
    PG8_WAIT_V(0);
    PG8_BAR;
#undef PG8_SA
#undef PG8_SB
#undef PG8_STAGE
#undef PG8_LDA
#undef PG8_LDB
#undef PG8_MMA
#undef PG8_WAIT_V
#undef PG8_WAIT_L
#undef PG8_BAR
#undef PG8_SCHED
}
}

struct EpiProj {
    static constexpr bool PERM = true;
    bf16_t* proj; const float* rrow; const float* tab; const float* qw; const float* kw;
    __device__ __forceinline__ void operator()(const f32x4 (&acc)[2][2][4][2], const pg8::Unit& u, int wr, int wc, int fr, int fq) const {
        const int pn = u.pn;
        if (pn < 5) {
            const float* nw = (pn < 4) ? qw : kw;
            bf16_t* base = (pn < 4) ? (proj + PO_Q + pn * 256) : (proj + PO_K);
            const int ldc = (pn < 4) ? 1024 : 256;
#pragma unroll
            for (int ai = 0; ai < 2; ++ai)
#pragma unroll
                for (int m = 0; m < 4; ++m) {
                    const int row = u.pm * 256 + ai * 128 + wr * 64 + m * 16 + fr;
                    const float rs = rrow[row];
                    const int s = row & (SEQ - 1), prow = s >> 6, pcol = s & 63;
                    float ss = 0.f;
#pragma unroll
                    for (int bj = 0; bj < 2; ++bj)
#pragma unroll
                        for (int n = 0; n < 2; ++n) { const f32x4 q = acc[ai][bj][m][n] * acc[ai][bj][m][n]; ss += (q[0] + q[1]) + (q[2] + q[3]); }
                    ss *= rs * rs;
                    ss += __shfl_xor(ss, 16); ss += __shfl_xor(ss, 32);
                    const float sc = rs / sqrtf(ss * (1.0f / 64.0f) + EPS);
#pragma unroll
                    for (int bj = 0; bj < 2; ++bj) {
                        const f32x4 c = *(const f32x4*)(tab + (bj ? TAB_COSC + pcol * 16 : TAB_COSR + prow * 16) + 4 * fq);
                        const f32x4 sn = *(const f32x4*)(tab + (bj ? TAB_SINC + pcol * 16 : TAB_SINR + prow * 16) + 4 * fq);
                        const f32x4 w0 = *(const f32x4*)(nw + 32 * bj + 4 * fq), w1 = *(const f32x4*)(nw + 32 * bj + 16 + 4 * fq);
                        const f32x4 x1 = acc[ai][bj][m][0] * sc * w0, x2 = acc[ai][bj][m][1] * sc * w1;
                        const f32x4 o1 = x1 * c - x2 * sn, o2 = x2 * c + x1 * sn;
                        u32x4 w; w.x = cvt_pk_bf16(o1[0], o1[1]); w.y = cvt_pk_bf16(o1[2], o1[3]); w.z = cvt_pk_bf16(o2[0], o2[1]); w.w = cvt_pk_bf16(o2[2], o2[3]);
                        *(u32x4*)(base + (size_t)row * ldc + wc * 64 + bj * 32 + 8 * fq) = w;
                    }
                    asm volatile("" ::: "memory");
                }
        } else {
            bf16_t* base; int ldc = 1024; bool f16 = false;
            if (pn == 5) { base = proj + PO_V; ldc = 256; }
            else { const int sg = (pn - 6) >> 2; base = proj + PO_AG + (size_t)sg * ((size_t)TH * 1024) + ((pn - 6) & 3) * 256; f16 = (sg == 2 || sg == 3); }
            const int col0 = wc * 32 + 8 * fq;
#pragma unroll
            for (int ai = 0; ai < 2; ++ai)
#pragma unroll
                for (int m = 0; m < 4; ++m) {
                    const int row = u.pm * 256 + ai * 128 + wr * 64 + m * 16 + fr;
                    const float rs = rrow[row];
                    bf16_t* rowp = base + (size_t)row * ldc + col0;
#pragma unroll
                    for (int bj = 0; bj < 2; ++bj) {
                        const f32x4 v0 = acc[ai][bj][m][0] * rs, v1 = acc[ai][bj][m][1] * rs; u32x4 w;
                        if (f16) { w.x = pack_h2(v0[0], v0[1]); w.y = pack_h2(v0[2], v0[3]); w.z = pack_h2(v1[0], v1[1]); w.w = pack_h2(v1[2], v1[3]); }
                        else { w.x = cvt_pk_bf16(v0[0], v0[1]); w.y = cvt_pk_bf16(v0[2], v0[3]); w.z = cvt_pk_bf16(v1[0], v1[1]); w.w = cvt_pk_bf16(v1[2], v1[3]); }
                        *(u32x4*)(rowp + bj * 128) = w;
                    }
                    if (m & 1) asm volatile("" ::: "memory");
                }
        }
    }
};
struct EpiMerge {
    static constexpr bool PERM = true;
    bf16_t* MA; const bf16_t* MH;
    __device__ __forceinline__ void operator()(const f32x4 (&acc)[2][2][4][2], const pg8::Unit& u, int wr, int wc, int fr, int fq) const {
        const int col0 = u.pn * 256 + wc * 32 + 8 * fq;
#pragma unroll
        for (int ai = 0; ai < 2; ++ai)
#pragma unroll
            for (int m = 0; m < 4; ++m) {
                const int row = u.pm * 256 + ai * 128 + wr * 64 + m * 16 + fr;
#pragma unroll
                for (int bj = 0; bj < 2; ++bj) {
                    const size_t off = (size_t)row * 1024 + col0 + bj * 128;
                    const u32x4 a = *(const u32x4*)(MA + off);
                    const f32x4 v0 = acc[ai][bj][m][0], v1 = acc[ai][bj][m][1];
                    float r[8];
                    if (u.z == 0) {
                        r[0] = sigmoidf_(bflo(a.x)) * v0[0]; r[1] = sigmoidf_(bfhi(a.x)) * v0[1]; r[2] = sigmoidf_(bflo(a.y)) * v0[2]; r[3] = sigmoidf_(bfhi(a.y)) * v0[3];
                        r[4] = sigmoidf_(bflo(a.z)) * v1[0]; r[5] = sigmoidf_(bfhi(a.z)) * v1[1]; r[6] = sigmoidf_(bflo(a.w)) * v1[2]; r[7] = sigmoidf_(bfhi(a.w)) * v1[3];
                    } else {
                        const u32x4 g = *(const u32x4*)(MH + off);
                        r[0] = bflo(a.x) + sigmoidf_(bflo(g.x)) * v0[0]; r[1] = bfhi(a.x) + sigmoidf_(bfhi(g.x)) * v0[1]; r[2] = bflo(a.y) + sigmoidf_(bflo(g.y)) * v0[2]; r[3] = bfhi(a.y) + sigmoidf_(bfhi(g.y)) * v0[3];
                        r[4] = bflo(a.z) + sigmoidf_(bflo(g.z)) * v1[0]; r[5] = bfhi(a.z) + sigmoidf_(bfhi(g.z)) * v1[1]; r[6] = bflo(a.w) + sigmoidf_(bflo(g.w)) * v1[2]; r[7] = bfhi(a.w) + sigmoidf_(bfhi(g.w)) * v1[3];
                    }
                    u32x4 w; w.x = cvt_pk_bf16(r[0], r[1]); w.y = cvt_pk_bf16(r[2], r[3]); w.z = cvt_pk_bf16(r[4], r[5]); w.w = cvt_pk_bf16(r[6], r[7]);
                    *(u32x4*)(MA + off) = w;
                    asm volatile("" ::: "memory");
                }
            }
    }
};
struct EpiResid {
    static constexpr bool PERM = false;
    const float* xin; float* out;
    __device__ __forceinline__ void operator()(const f32x4 (&acc)[2][2][4][2], const pg8::Unit& u, int wr, int wc, int fr, int fq) const {
        const int col0 = u.pn * 256 + wc * 32 + 4 * fq;
#pragma unroll
        for (int ai = 0; ai < 2; ++ai)
#pragma unroll
            for (int m = 0; m < 4; ++m) {
                const size_t off = (size_t)(u.pm * 256 + ai * 128 + wr * 64 + m * 16 + fr) * 1024 + col0;
#pragma unroll
                for (int bj = 0; bj < 2; ++bj)
#pragma unroll
                    for (int n = 0; n < 2; ++n) { const f32x4 b = *(const f32x4*)(xin + off + bj * 128 + n * 16); *(f32x4*)(out + off + bj * 128 + n * 16) = b + acc[ai][bj][m][n]; }
                if (m & 1) asm volatile("" ::: "memory");
            }
    }
};

namespace att {
constexpr int QBLK = 32, KVBLK = 64, LDQ = 1024, LDK = 256;
constexpr float SCALE = 0.125f, THR = 8.f;
constexpr int SHM_V = 8192, SHM_K = 8192;
__device__ __forceinline__ int crow(int r, int hi) { return (r & 3) + 8 * (r >> 2) + 4 * hi; }
#define SBAR() __builtin_amdgcn_sched_barrier(0)
__device__ __forceinline__ void partialSM(f32x16& p0, f32x16& p1, float& m_reg, float& mn, float& alpha) {
    constexpr float C = SCALE * 1.4426950408889634f;
    float pmax = p0[0];
#pragma unroll
    for (int r = 1; r < 16; ++r) pmax = fmaxf(pmax, p0[r]);
#pragma unroll
    for (int r = 0; r < 16; ++r) pmax = fmaxf(pmax, p1[r]);
    { auto rr = __builtin_amdgcn_permlane32_swap(__float_as_uint(pmax), __float_as_uint(pmax), false, false); pmax = fmaxf(__uint_as_float(rr[0]), __uint_as_float(rr[1])); }
    if (__builtin_expect(__all(pmax - m_reg <= THR / SCALE), 1)) { mn = m_reg; alpha = 1.f; }
    else { mn = fmaxf(m_reg, pmax); alpha = __builtin_amdgcn_exp2f((m_reg - mn) * C); m_reg = mn; }
    const float mnC = -mn * C;
#pragma unroll
    for (int r = 0; r < 16; ++r) p0[r] = fmaf(p0[r], C, mnC);
#pragma unroll
    for (int r = 0; r < 16; ++r) p1[r] = fmaf(p1[r], C, mnC);
#pragma unroll
    for (int r = 0; r < 16; ++r) p0[r] = __builtin_amdgcn_exp2f(p0[r]);
}
__device__ __forceinline__ void finishSM(f32x16& p0, f32x16& p1, float alpha, float& l_reg, bf16x8& pa0, bf16x8& pa1, bf16x8& pa2, bf16x8& pa3) {
#pragma unroll
    for (int r = 0; r < 16; ++r) p1[r] = __builtin_amdgcn_exp2f(p1[r]);
    float ps = 0;
#pragma unroll
    for (int r = 0; r < 16; ++r) ps += p0[r];
#pragma unroll
    for (int r = 0; r < 16; ++r) ps += p1[r];
    { auto rr = __builtin_amdgcn_permlane32_swap(__float_as_uint(ps), __float_as_uint(ps), false, false); ps = __uint_as_float(rr[0]) + __uint_as_float(rr[1]); }
    l_reg = l_reg * alpha + ps;
#define PK4(P, BASE, OUT) do { unsigned a0 = cvt_pk_bf16(P[BASE + 0], P[BASE + 1]), a1 = cvt_pk_bf16(P[BASE + 2], P[BASE + 3]);   \
    unsigned b0 = cvt_pk_bf16(P[BASE + 4], P[BASE + 5]), b1 = cvt_pk_bf16(P[BASE + 6], P[BASE + 7]);                              \
    auto r0 = __builtin_amdgcn_permlane32_swap(a0, b0, false, false); auto r1 = __builtin_amdgcn_permlane32_swap(a1, b1, false, false); \
    u32x4 w = {r0[0], r1[0], r0[1], r1[1]}; OUT = *reinterpret_cast<bf16x8*>(&w); } while (0)
    PK4(p0, 0, pa0); PK4(p0, 8, pa1); PK4(p1, 0, pa2); PK4(p1, 8, pa3);
#undef PK4
}
__device__ __forceinline__ void qkt(f32x16& p0, f32x16& p1, const char* Ks, const bf16x8* qr, int r32, int hi) {
    p0 = f32x16{}; p1 = f32x16{};
#pragma unroll
    for (int d0 = 0; d0 < 4; ++d0) {
        const bf16x8 b0 = *reinterpret_cast<const bf16x8*>(Ks + (2 * d0 + hi) * 1024 + r32 * 16);
        const bf16x8 b1 = *reinterpret_cast<const bf16x8*>(Ks + (2 * d0 + hi) * 1024 + 512 + r32 * 16);
        p0 = __builtin_amdgcn_mfma_f32_32x32x16_bf16(b0, qr[d0], p0, 0, 0, 0);
        p1 = __builtin_amdgcn_mfma_f32_32x32x16_bf16(b1, qr[d0], p1, 0, 0, 0); }
}
__device__ __forceinline__ int v_st(int k, int c) { const int kk = (k & ~0xC) | ((k & 4) << 1) | ((k & 8) >> 1); return ((kk >> 3) * 2 + (c >> 5)) * 512 + ((kk & 7) * 32 + (c & 31)) * 2; }
__device__ __forceinline__ int v_rd_base(int lane) { return ((lane & 3) << 3) | (((lane >> 2) & 3) << 6) | (((lane >> 4) & 1) << 5) | (((lane >> 5) & 1) << 8); }
constexpr int v_rd_off(int d0, int ks, int half) { return d0 * 512 + ks * 2048 + half * 1024; }
template <int OFF> __device__ __forceinline__ s16x4 tr_read(int vb) { s16x4 r; asm volatile("ds_read_b64_tr_b16 %0, %1 offset:%2" : "=&v"(r) : "v"(vb), "i"(OFF) : "memory"); return r; }
template <int D0> __device__ __forceinline__ void pv_one(f32x16& od, int vb, bf16x8 pa0, bf16x8 pa1, bf16x8 pa2, bf16x8 pa3) {
    const s16x4 l0 = tr_read<v_rd_off(D0, 0, 0)>(vb), h0 = tr_read<v_rd_off(D0, 0, 1)>(vb), l1 = tr_read<v_rd_off(D0, 1, 0)>(vb), h1 = tr_read<v_rd_off(D0, 1, 1)>(vb);
    const s16x4 l2 = tr_read<v_rd_off(D0, 2, 0)>(vb), h2 = tr_read<v_rd_off(D0, 2, 1)>(vb), l3 = tr_read<v_rd_off(D0, 3, 0)>(vb), h3 = tr_read<v_rd_off(D0, 3, 1)>(vb);
    asm volatile("s_waitcnt lgkmcnt(0)" ::: "memory"); SBAR();
#define PK(L, H) (bf16x8){L[0], L[1], L[2], L[3], H[0], H[1], H[2], H[3]}
    od = __builtin_amdgcn_mfma_f32_32x32x16_bf16(pa0, PK(l0, h0), od, 0, 0, 0);
    od = __builtin_amdgcn_mfma_f32_32x32x16_bf16(pa1, PK(l1, h1), od, 0, 0, 0);
    od = __builtin_amdgcn_mfma_f32_32x32x16_bf16(pa2, PK(l2, h2), od, 0, 0, 0);
    od = __builtin_amdgcn_mfma_f32_32x32x16_bf16(pa3, PK(l3, h3), od, 0, 0, 0);
#undef PK
}
__device__ __forceinline__ void pv_d0(f32x16* o, int vb, bf16x8 pa0, bf16x8 pa1, bf16x8 pa2, bf16x8 pa3) { pv_one<0>(o[0], vb, pa0, pa1, pa2, pa3); pv_one<1>(o[1], vb, pa0, pa1, pa2, pa3); }

__device__ __forceinline__ void attn_unit(bf16_t* Qb, const bf16_t* __restrict__ Kh, const bf16_t* __restrict__ Vh, const bf16_t* __restrict__ Gb, char* lds) {
    int tid = threadIdx.x; asm volatile("" : "+v"(tid));
    const int wid = tid >> 6, lane = tid & 63, r32 = lane & 31, hi = lane >> 5;
    char* V_lds = lds; char* K_lds = lds + 2 * SHM_V;
    float* ws = (float*)(lds + 2 * SHM_V + 2 * SHM_K) + wid * 64; float* li_l = ws; float* al_l = ws + 32;
    float m_reg = -1e30f, l_reg = 0; f32x16 o[2] = {}; bf16x8 qr[4];
    const bf16_t* Qw = Qb + (size_t)(wid * QBLK + r32) * LDQ + hi * 8;
#pragma unroll
    for (int d0 = 0; d0 < 4; ++d0) qr[d0] = *reinterpret_cast<const bf16x8*>(Qw + d0 * 16);
    const int krow = tid & 63, kch = tid >> 6, kst = kch * 1024 + krow * 16;
    const int sr = tid >> 3, sc = (tid & 7) * 8, vst0 = v_st(sr, sc);
    const int vb0 = (int)(uintptr_t)V_lds + v_rd_base(lane);
    bf16x8 svA, skA, svB, skB;
#define SLOADA(k0) do { svA = *reinterpret_cast<const bf16x8*>(&Vh[(size_t)((k0) + sr) * LDK + sc]); skA = *reinterpret_cast<const bf16x8*>(&Kh[(size_t)((k0) + krow) * LDK + kch * 8]); } while (0)
#define SLOADB(k0) do { svB = *reinterpret_cast<const bf16x8*>(&Vh[(size_t)((k0) + sr) * LDK + sc]); skB = *reinterpret_cast<const bf16x8*>(&Kh[(size_t)((k0) + krow) * LDK + kch * 8]); } while (0)
#define SWRITEA(b) do { *(bf16x8*)(V_lds + (b) * SHM_V + vst0) = svA; *(bf16x8*)(K_lds + (b) * SHM_K + kst) = skA; } while (0)
#define SWRITEB(b) do { *(bf16x8*)(V_lds + (b) * SHM_V + vst0) = svB; *(bf16x8*)(K_lds + (b) * SHM_K + kst) = skB; } while (0)
#define SWAIT() asm volatile("s_waitcnt vmcnt(2)" ::: "memory")
#define RESC(a) do { if (__any((a) < 1.f)) { if (hi == 0) al_l[r32] = (a); asm volatile("s_waitcnt lgkmcnt(0)" ::: "memory"); \
    _Pragma("unroll") for (int d = 0; d < 2; ++d) _Pragma("unroll") for (int r = 0; r < 16; ++r) o[d][r] *= al_l[crow(r, hi)]; } } while (0)
    f32x16 pA0, pA1, pB0, pB1; float mnA, mnB, alA, alB; bf16x8 pa0, pa1, pa2, pa3; constexpr int NT = SEQ / KVBLK;
    SLOADA(0); asm volatile("s_waitcnt vmcnt(0)" ::: "memory"); SWRITEA(0); __syncthreads();
    qkt(pA0, pA1, K_lds, qr, r32, hi); partialSM(pA0, pA1, m_reg, mnA, alA);
    SLOADB(KVBLK); SLOADA(2 * KVBLK);
    SWAIT(); SWRITEB(1); __syncthreads();
    for (int j = 1; j + 1 < NT; j += 2) {
        SBAR(); qkt(pB0, pB1, K_lds + SHM_K, qr, r32, hi);
        finishSM(pA0, pA1, alA, l_reg, pa0, pa1, pa2, pa3); SBAR();
        SLOADB((j + 2) * KVBLK); SBAR();
        pv_d0(o, vb0, pa0, pa1, pa2, pa3); partialSM(pB0, pB1, m_reg, mnB, alB);
        __syncthreads(); SWAIT(); SWRITEA(0);
        RESC(alB); __syncthreads();
        SBAR(); qkt(pA0, pA1, K_lds, qr, r32, hi);
        finishSM(pB0, pB1, alB, l_reg, pa0, pa1, pa2, pa3); SBAR();
        if (j + 3 < NT) SLOADA((j + 3) * KVBLK); SBAR();
        pv_d0(o, vb0 + SHM_V, pa0, pa1, pa2, pa3); partialSM(pA0, pA1, m_reg, mnA, alA);
        __syncthreads(); SWAIT(); SWRITEB(1);
        RESC(alA); __syncthreads();
    }
    SBAR(); qkt(pB0, pB1, K_lds + SHM_K, qr, r32, hi);
    finishSM(pA0, pA1, alA, l_reg, pa0, pa1, pa2, pa3); SBAR();
    pv_d0(o, vb0, pa0, pa1, pa2, pa3); partialSM(pB0, pB1, m_reg, mnB, alB);
    __syncthreads(); RESC(alB);
    finishSM(pB0, pB1, alB, l_reg, pa0, pa1, pa2, pa3); SBAR();
    pv_d0(o, vb0 + SHM_V, pa0, pa1, pa2, pa3);
    if (hi == 0) li_l[r32] = l_reg; asm volatile("s_waitcnt lgkmcnt(0)" ::: "memory");
    float rli[16];
#pragma unroll
    for (int r = 0; r < 16; ++r) rli[r] = __builtin_amdgcn_rcpf(li_l[crow(r, hi)]);
    __syncthreads();
    bf16_t* stg = (bf16_t*)lds + wid * 2048;
#pragma unroll
    for (int r = 0; r < 16; ++r) { const int orow = crow(r, hi);
#pragma unroll
        for (int d0 = 0; d0 < 2; ++d0) stg[orow * 64 + d0 * 32 + r32] = (bf16_t)(cvt_pk_bf16(o[d0][r] * rli[r], 0.f) & 0xffffu); }
    asm volatile("s_waitcnt lgkmcnt(0)" ::: "memory");
#pragma unroll
    for (int i = 0; i < 4; ++i) {
        const int row = i * 8 + (lane >> 3), ch = lane & 7;
        const u32x4 v = *(const u32x4*)(stg + row * 64 + ch * 8);
        const size_t goff = (size_t)(wid * QBLK + row) * LDQ + ch * 8;
        const u32x4 g = *(const u32x4*)(Gb + goff);
        u32x4 w;
        w.x = cvt_pk_bf16(bflo(v.x) * siluf_(bflo(g.x)), bfhi(v.x) * siluf_(bfhi(g.x))); w.y = cvt_pk_bf16(bflo(v.y) * siluf_(bflo(g.y)), bfhi(v.y) * siluf_(bfhi(g.y)));
        w.z = cvt_pk_bf16(bflo(v.z) * siluf_(bflo(g.z)), bfhi(v.z) * siluf_(bfhi(g.z))); w.w = cvt_pk_bf16(bflo(v.w) * siluf_(bflo(g.w)), bfhi(v.w) * siluf_(bfhi(g.w)));
        *(u32x4*)(Qb + goff) = w;
    }
    __syncthreads();
#undef SLOADA
#undef SLOADB
#undef SWRITEA
#undef SWRITEB
#undef SWAIT
#undef RESC
}
}

namespace hg {
constexpr int QRAW = 0, ZRAW = 8192, VRAW = 16384, QT = 24576, KT = QT + 8704, KDT = KT + 8704, DL = KDT + 10240, TOT = DL + 512, OT = TOT + 1024, GROUP_BYTES = OT + 16384;
constexpr int NC = SEQ / 32;
__device__ __forceinline__ int crow(int r, int hi) { return (r & 3) + 8 * (r >> 2) + 4 * hi; }
__device__ __forceinline__ void hgrn_item(char* lds, bf16_t* proj, int bl, int h, const float* lb0, const float* lb1, const float* gw) {
    int tid = threadIdx.x; asm volatile("" : "+v"(tid));
    const int gd = tid >> 8, gt = tid & 255, lane = tid & 63, wv = (tid >> 6) & 3, r32 = lane & 31, hi = lane >> 5;
    char* G = lds + gd * GROUP_BYTES;
    const size_t hb = (size_t)bl * SEQ * 1024 + h * 128;
    bf16_t* HQp = proj + PO_HQ + hb;
    const bf16_t* Zp = proj + (gd ? PO_ZB : PO_ZF) + hb;
    bf16_t* PW = proj + (gd ? PO_ZB : PO_ZF) + hb;
    const bf16_t* PR = proj + (gd ? PO_ZF : PO_ZB) + hb;
    const bf16_t* HIp = proj + PO_HI + hb; const bf16_t* HGp = proj + PO_HG + hb;
    const int k = gt & 127, th = gt >> 7;
    const float lbk = (gd ? lb1 : lb0)[h * 128 + k], oml = 1.0f - lbk;
    f32x16 sacc[4];
#pragma unroll
    for (int i = 0; i < 4; ++i) sacc[i] = f32x16{};
    u32x4 pq[2], pz[2], pv[2];
    const int prow[2] = {gt >> 4, (gt + 256) >> 4}; const int pc8 = (gt & 15) * 8;
#define HG_LOAD(c) do { _Pragma("unroll") for (int ii = 0; ii < 2; ++ii) { const size_t go = (size_t)((c) * 32 + prow[ii]) * 1024 + pc8; \
        pq[ii] = *(const u32x4*)(HQp + go); pz[ii] = *(const u32x4*)(Zp + go); pv[ii] = *(const u32x4*)(HIp + go); } } while (0)
    HG_LOAD(gd ? NC - 1 : 0);
    for (int i = 0; i < NC; ++i) {
        const int c = gd ? NC - 1 - i : i;
#pragma unroll
        for (int ii = 0; ii < 2; ++ii) { const int lo = prow[ii] * 256 + pc8 * 2; *(u32x4*)(G + QRAW + lo) = pq[ii]; *(u32x4*)(G + ZRAW + lo) = pz[ii]; *(u32x4*)(G + VRAW + lo) = pv[ii]; }
        if (i + 1 < NC) { const int cn = gd ? c - 1 : c + 1; HG_LOAD(cn); }
        LDS_BAR();
        float fe[16], Pl[16]; float P = 1.0f;
#pragma unroll
        for (int j = 0; j < 16; ++j) { const int t = 16 * th + j, row = gd ? 31 - t : t;
            const float z = h2f(*(const unsigned short*)(G + ZRAW + row * 256 + k * 2));
            const float e = __expf(-z), sg = 1.0f / (1.0f + e);
            const float f = lbk + oml * sg; P *= f; Pl[j] = P; fe[j] = oml * e * sg; }
        ((float*)(G + TOT))[th * 128 + k] = P;
        LDS_BAR();
        {
            const float t0 = ((const float*)(G + TOT))[k], t1 = ((const float*)(G + TOT))[128 + k];
            const float pre = th ? t0 : 1.0f, plast = t0 * t1;
            unsigned kdw[8];
#pragma unroll
            for (int j = 0; j < 16; j += 2) {
                float kd2[2];
#pragma unroll
                for (int jj = 0; jj < 2; ++jj) { const int t = 16 * th + j + jj, row = gd ? 31 - t : t;
                    const float q = bf2f(*(const unsigned short*)(G + QRAW + row * 256 + k * 2));
                    const float sq = siluf_(q) * 0.08838834764831845f;
                    const float Pt = pre * Pl[j + jj];
                    const float kt = fe[j + jj] / fmaxf(Pt, 1e-30f);
                    *(unsigned short*)(G + QT + t * 272 + k * 2) = (unsigned short)(cvt_pk_bf16(sq * Pt, 0.f) & 0xffffu);
                    *(unsigned short*)(G + KT + t * 272 + k * 2) = (unsigned short)(cvt_pk_bf16(kt, 0.f) & 0xffffu);
                    kd2[jj] = kt * plast; }
                kdw[j >> 1] = cvt_pk_bf16(kd2[0], kd2[1]);
            }
            *(u32x4*)(G + KDT + k * 80 + th * 32) = (u32x4){kdw[0], kdw[1], kdw[2], kdw[3]};
            *(u32x4*)(G + KDT + k * 80 + th * 32 + 16) = (u32x4){kdw[4], kdw[5], kdw[6], kdw[7]};
            if (th == 0) ((float*)(G + DL))[k] = plast;
        }
        LDS_BAR();
        {
            f32x16 X = f32x16{};
#pragma unroll
            for (int ks = 0; ks < 8; ++ks) {
                const bf16x8 a = *(const bf16x8*)(G + KT + r32 * 272 + (16 * ks + 8 * hi) * 2);
                const bf16x8 b = *(const bf16x8*)(G + QT + r32 * 272 + (16 * ks + 8 * hi) * 2);
                X = __builtin_amdgcn_mfma_f32_32x32x16_bf16(a, b, X, 0, 0, 0);
            }
#pragma unroll
            for (int r = 0; r < 16; ++r) X[r] = (crow(r, hi) <= r32) ? X[r] : 0.0f;
            bf16x8 pa[2], vb[2];
#pragma unroll
            for (int sp = 0; sp < 2; ++sp) {
                u32x4 w; w.x = cvt_pk_bf16(X[8 * sp + 0], X[8 * sp + 1]); w.y = cvt_pk_bf16(X[8 * sp + 2], X[8 * sp + 3]); w.z = cvt_pk_bf16(X[8 * sp + 4], X[8 * sp + 5]); w.w = cvt_pk_bf16(X[8 * sp + 6], X[8 * sp + 7]);
                pa[sp] = __builtin_bit_cast(bf16x8, w);
#pragma unroll
                for (int j = 0; j < 8; ++j) { const int s = crow(8 * sp + j, hi), row = gd ? 31 - s : s;
                    vb[sp][j] = *(const short*)(G + VRAW + row * 256 + (32 * wv + r32) * 2); }
            }
            f32x16 oacc = f32x16{};
            oacc = __builtin_amdgcn_mfma_f32_32x32x16_bf16(pa[0], vb[0], oacc, 0, 0, 0);
            oacc = __builtin_amdgcn_mfma_f32_32x32x16_bf16(pa[1], vb[1], oacc, 0, 0, 0);
#pragma unroll
            for (int kt = 0; kt < 4; ++kt) {
#pragma unroll
                for (int sp = 0; sp < 2; ++sp) {
                    u32x4 w; w.x = cvt_pk_bf16(sacc[kt][8 * sp + 0], sacc[kt][8 * sp + 1]); w.y = cvt_pk_bf16(sacc[kt][8 * sp + 2], sacc[kt][8 * sp + 3]);
                    w.z = cvt_pk_bf16(sacc[kt][8 * sp + 4], sacc[kt][8 * sp + 5]); w.w = cvt_pk_bf16(sacc[kt][8 * sp + 6], sacc[kt][8 * sp + 7]);
                    const bf16x8 sb = __builtin_bit_cast(bf16x8, w);
                    const s16x4 lo = *(const s16x4*)(G + QT + r32 * 272 + (32 * kt + 16 * sp + 4 * hi) * 2);
                    const s16x4 h4 = *(const s16x4*)(G + QT + r32 * 272 + (32 * kt + 16 * sp + 8 + 4 * hi) * 2);
                    const bf16x8 qa = (bf16x8){lo[0], lo[1], lo[2], lo[3], h4[0], h4[1], h4[2], h4[3]};
                    oacc = __builtin_amdgcn_mfma_f32_32x32x16_bf16(qa, sb, oacc, 0, 0, 0);
                }
            }
#pragma unroll
            for (int kt = 0; kt < 4; ++kt) {
#pragma unroll
                for (int rq = 0; rq < 4; ++rq) { const f32x4 d4 = *(const f32x4*)(G + DL + (32 * kt + 8 * rq + 4 * hi) * 4);
                    sacc[kt][4 * rq + 0] *= d4[0]; sacc[kt][4 * rq + 1] *= d4[1]; sacc[kt][4 * rq + 2] *= d4[2]; sacc[kt][4 * rq + 3] *= d4[3]; }
#pragma unroll
                for (int sp = 0; sp < 2; ++sp) {
                    const s16x4 lo = *(const s16x4*)(G + KDT + (32 * kt + r32) * 80 + (16 * sp + 4 * hi) * 2);
                    const s16x4 h4 = *(const s16x4*)(G + KDT + (32 * kt + r32) * 80 + (16 * sp + 8 + 4 * hi) * 2);
                    const bf16x8 ka = (bf16x8){lo[0], lo[1], lo[2], lo[3], h4[0], h4[1], h4[2], h4[3]};
                    sacc[kt] = __builtin_amdgcn_mfma_f32_32x32x16_bf16(ka, vb[sp], sacc[kt], 0, 0, 0);
                }
            }
#pragma unroll
            for (int r = 0; r < 16; ++r) ((float*)(G + OT))[crow(r, hi) * 128 + 32 * wv + r32] = oacc[r];
        }
        LDS_BAR();
        {
            const int t = gt >> 3, c16 = (gt & 7) * 16, row = gd ? 31 - t : t;
            const size_t go = (size_t)(c * 32 + row) * 1024 + c16;
            float ov[16];
#pragma unroll
            for (int q4 = 0; q4 < 4; ++q4) { const f32x4 v = *(const f32x4*)(G + OT + (t * 128 + c16 + 4 * q4) * 4); ov[4 * q4] = v[0]; ov[4 * q4 + 1] = v[1]; ov[4 * q4 + 2] = v[2]; ov[4 * q4 + 3] = v[3]; }
            if (i < NC / 2) {
                u32x4 w0, w1;
                w0.x = cvt_pk_bf16(ov[0], ov[1]); w0.y = cvt_pk_bf16(ov[2], ov[3]); w0.z = cvt_pk_bf16(ov[4], ov[5]); w0.w = cvt_pk_bf16(ov[6], ov[7]);
                w1.x = cvt_pk_bf16(ov[8], ov[9]); w1.y = cvt_pk_bf16(ov[10], ov[11]); w1.z = cvt_pk_bf16(ov[12], ov[13]); w1.w = cvt_pk_bf16(ov[14], ov[15]);
                *(u32x4*)(PW + go) = w0; *(u32x4*)(PW + go + 8) = w1;
            } else {
                const unsigned long long* pp = (const unsigned long long*)(PR + go);
                unsigned long long pw[4];
#pragma unroll
                for (int q4 = 0; q4 < 4; ++q4) pw[q4] = __hip_atomic_load(pp + q4, __ATOMIC_RELAXED, __HIP_MEMORY_SCOPE_AGENT);
                float ss = 0.f;
#pragma unroll
                for (int q4 = 0; q4 < 4; ++q4) { const unsigned lo = (unsigned)pw[q4], hi2 = (unsigned)(pw[q4] >> 32);
                    ov[4 * q4] += bflo(lo); ov[4 * q4 + 1] += bfhi(lo); ov[4 * q4 + 2] += bflo(hi2); ov[4 * q4 + 3] += bfhi(hi2); }
#pragma unroll
                for (int j = 0; j < 16; ++j) ss += ov[j] * ov[j];
                ss += __shfl_xor(ss, 1); ss += __shfl_xor(ss, 2); ss += __shfl_xor(ss, 4);
                const float rstd = 1.0f / sqrtf(ss * (1.0f / 128.0f) + EPS);
                const u32x4 g0 = *(const u32x4*)(HGp + go), g1 = *(const u32x4*)(HGp + go + 8);
                const unsigned gg[8] = {g0.x, g0.y, g0.z, g0.w, g1.x, g1.y, g1.z, g1.w};
                unsigned wo[8];
#pragma unroll
                for (int j = 0; j < 8; ++j) { const float a = ov[2 * j] * rstd * gw[c16 + 2 * j] * siluf_(bflo(gg[j])), b = ov[2 * j + 1] * rstd * gw[c16 + 2 * j + 1] * siluf_(bfhi(gg[j])); wo[j] = cvt_pk_bf16(a, b); }
                *(u32x4*)(HQp + go) = (u32x4){wo[0], wo[1], wo[2], wo[3]}; *(u32x4*)(HQp + go + 8) = (u32x4){wo[4], wo[5], wo[6], wo[7]};
            }
        }
        asm volatile("s_waitcnt vmcnt(0)" ::: "memory");
        LDS_BAR();
    }
#undef HG_LOAD
}
}

__device__ __forceinline__ void transpose_w(const float* __restrict__ W, int K, int N, bf16_t* __restrict__ out, const float* __restrict__ ksc, bool permqk, long gtid, long gthreads) {
    const long total = (long)N * (K / 8);
    for (long idx = gtid; idx < total; idx += gthreads) {
        const int nv = (int)(idx % N), kg = (int)(idx / N);
        int nr = nv;
        if (permqk && nv < 1280) { const int cv = nv & 255; const int bj = cv >> 7, wc = (cv >> 5) & 3, fq = (cv >> 3) & 3, n = (cv >> 2) & 1, e = cv & 3; nr = (nv & ~255) + 64 * wc + 32 * bj + 16 * n + 4 * fq + e; }
        float v[8];
#pragma unroll
        for (int j = 0; j < 8; ++j) { const int kk = kg * 8 + j; v[j] = W[(size_t)kk * N + nr] * (ksc ? ksc[kk] : 1.0f); }
        u32x4 w; w.x = cvt_pk_bf16(v[0], v[1]); w.y = cvt_pk_bf16(v[2], v[3]); w.z = cvt_pk_bf16(v[4], v[5]); w.w = cvt_pk_bf16(v[6], v[7]);
        *(u32x4*)(out + (size_t)nv * K + kg * 8) = w;
    }
}
__device__ __forceinline__ void rowprep(const float* __restrict__ x, bf16_t* __restrict__ xb, float* __restrict__ rrow, int gwave, int nwaves, int lane) {
    for (int row = gwave; row < NTOK; row += nwaves) {
        const float* xr = x + (size_t)row * DM; float ss = 0.f; f32x4 v[4];
#pragma unroll
        for (int i = 0; i < 4; ++i) { v[i] = *(const f32x4*)(xr + 4 * lane + 256 * i); const f32x4 q = v[i] * v[i]; ss += (q[0] + q[1]) + (q[2] + q[3]); }
#pragma unroll
        for (int o = 1; o < 64; o <<= 1) ss += __shfl_xor(ss, o);
        if (lane == 0) rrow[row] = 1.0f / sqrtf(ss * (1.0f / DM) + EPS);
#pragma unroll
        for (int i = 0; i < 4; ++i) { u32x2 w; w.x = cvt_pk_bf16(v[i][0], v[i][1]); w.y = cvt_pk_bf16(v[i][2], v[i][3]); *(u32x2*)(xb + (size_t)row * DM + 4 * lane + 256 * i) = w; }
    }
}
__device__ __forceinline__ void final_norm(float* __restrict__ x, const float* __restrict__ fw, int gwave, int nwaves, int lane) {
    for (int row = gwave; row < NTOK; row += nwaves) {
        float* xr = x + (size_t)row * DM; float ss = 0.f; f32x4 v[4];
#pragma unroll
        for (int i = 0; i < 4; ++i) { v[i] = *(const f32x4*)(xr + 4 * lane + 256 * i); const f32x4 q = v[i] * v[i]; ss += (q[0] + q[1]) + (q[2] + q[3]); }
#pragma unroll
        for (int o = 1; o < 64; o <<= 1) ss += __shfl_xor(ss, o);
        const float r = 1.0f / sqrtf(ss * (1.0f / DM) + EPS);
#pragma unroll
        for (int i = 0; i < 4; ++i) { const f32x4 w = *(const f32x4*)(fw + 4 * lane + 256 * i); *(f32x4*)(xr + 4 * lane + 256 * i) = v[i] * r * w; }
    }
}

constexpr int ATT_LDS = 2 * att::SHM_V + 2 * att::SHM_K + 8 * 64 * 4;
constexpr int LDS_BYTES = (2 * hg::GROUP_BYTES > pg8::STAGE_BYTES ? 2 * hg::GROUP_BYTES : pg8::STAGE_BYTES);
static_assert(ATT_LDS <= LDS_BYTES, "lds");
#ifndef PH_MASK
#define PH_MASK 31
#endif
#ifndef ATT_UA
#define ATT_UA 10
#endif
constexpr int UA = ATT_UA, UB = 16 - ATT_UA;

__global__ void __launch_bounds__(NTHREADS, 2) fwd_megakernel(Params p) {
    extern __shared__ __attribute__((aligned(16))) unsigned char lds[];
    cg::grid_group grid = cg::this_grid();
    const int G = gridDim.x, c = blockIdx.x;
#define IDS() int tid_ = threadIdx.x; asm volatile("" : "+v"(tid_)); const int lane = tid_ & 63; const long gtid = (long)blockIdx.x * NTHREADS + tid_, gthreads = (long)gridDim.x * NTHREADS; const int gwave = (int)(gtid >> 6), nwaves = (int)(gthreads >> 6); (void)lane; (void)gwave; (void)nwaves;
typedef const __attribute__((address_space(4))) Params* KPtr;
#define KP() ({ KPtr _k = (KPtr)__builtin_amdgcn_kernarg_segment_ptr(); asm volatile("" : "+s"(_k)); _k; })
#define WSP(kp, off) ((kp)->ws + (off))
    { IDS();
    for (int l = 0; l < DEPTH; ++l) {
        KPtr kp = KP();
        transpose_w(kp->w_in + (size_t)l * DM * NIN, DM, NIN, (bf16_t*)WSP(kp, WS_WIN) + (size_t)l * NIN * DM, kp->norm_w + l * DM, true, gtid, gthreads);
        transpose_w(kp->w_ba + (size_t)l * DM * DM, DM, DM, (bf16_t*)WSP(kp, WS_WA) + (size_t)l * DM * DM, nullptr, false, gtid, gthreads);
        transpose_w(kp->w_bh + (size_t)l * DM * DM, DM, DM, (bf16_t*)WSP(kp, WS_WH) + (size_t)l * DM * DM, nullptr, false, gtid, gthreads);
        transpose_w(kp->w_out + (size_t)l * DM * DM, DM, DM, (bf16_t*)WSP(kp, WS_WO) + (size_t)l * DM * DM, nullptr, false, gtid, gthreads);
    }
    { KPtr kp = KP(); float* TAB = (float*)WSP(kp, WS_TAB);
    if (gtid < 1536) {
        const int pos = (int)(gtid >> 4), i = (int)(gtid & 15);
        const float inv = powf(10000.0f, -(float)i / 16.0f);
        if (pos < 32) { const float a = (float)pos * inv; TAB[TAB_COSR + pos * 16 + i] = cosf(a); TAB[TAB_SINR + pos * 16 + i] = sinf(a); }
        else { const int pc = pos - 32; const float a = (float)pc * inv; TAB[TAB_COSC + pc * 16 + i] = cosf(a); TAB[TAB_SINC + pc * 16 + i] = sinf(a); }
    }
    if (gtid >= 2048 && gtid < 2048 + 2048) {
        const int d = (int)((gtid - 2048) >> 10), k = (int)((gtid - 2048) & 1023);
        const float a0 = kp->lbnd[(size_t)(d * DEPTH + 0) * 1024 + k], a1 = kp->lbnd[(size_t)(d * DEPTH + 1) * 1024 + k];
        const float m = fmaxf(a0, a1), e0 = expf(a0 - m), e1 = expf(a1 - m);
        TAB[TAB_LB + (d * 2 + 0) * 1024 + k] = 0.0f; TAB[TAB_LB + (d * 2 + 1) * 1024 + k] = e1 / (e0 + e1);
    }
    rowprep(kp->x, (bf16_t*)WSP(kp, WS_XB), (float*)WSP(kp, WS_RROW), gwave, nwaves, lane); } }
    grid.sync();

    for (int layer = 0; layer < DEPTH; ++layer) {
        for (int half = 0; half < 2; ++half) {
            const size_t tok0 = (size_t)half * TH;
#if PH_MASK & 1
            {
                KPtr kp = KP();
                pg8::Gemm g{(const bf16_t*)WSP(kp, WS_XB) + tok0 * DM, (const bf16_t*)WSP(kp, WS_WIN) + (size_t)layer * NIN * DM, nullptr, nullptr, TH, NIN, DM};
                pg8::StaticOrder S; S.init(TH, NIN, G, c);
                EpiProj E{(bf16_t*)WSP(kp, WS_PROJ), (const float*)WSP(kp, WS_RROW) + tok0, (const float*)WSP(kp, WS_TAB), kp->q_norm_w + layer * 64, kp->k_norm_w + layer * 64};
                pg8::gemm_phase<EpiProj, pg8::StaticOrder>((LAS unsigned char*)lds, g, S, E);
            }
#endif
            grid.sync();
            {
                KPtr kp = KP();
                bf16_t* PROJ = (bf16_t*)WSP(kp, WS_PROJ); const float* TAB = (const float*)WSP(kp, WS_TAB);
                const int xcd = c & 7, j = c >> 3;
                const bool light = c < 128;
#if PH_MASK & 2
                if (light) hg::hgrn_item((char*)lds, PROJ, c >> 3, c & 7, TAB + TAB_LB + (0 * 2 + layer) * 1024, TAB + TAB_LB + (1 * 2 + layer) * 1024, kp->hnorm_w + layer * 128);
#endif
                __syncthreads();
                const int nun = light ? UB : UA, ubase = light ? 16 * UA + j : (j - 16);
#if PH_MASK & 4
                for (int i = 0; i < nun; ++i) {
                    const int u = ubase + 16 * i, grp = xcd * 8 + (u >> 5), w = u & 31;
                    const int bl = grp >> 2, kvh = grp & 3, head = kvh * 4 + (w & 3), qb = w >> 2;
                    const size_t r0 = (size_t)bl * SEQ;
                    att::attn_unit(PROJ + PO_Q + (r0 + qb * 256) * 1024 + head * 64, PROJ + PO_K + r0 * 256 + kvh * 64, PROJ + PO_V + r0 * 256 + kvh * 64,
                                   PROJ + PO_AG + (r0 + qb * 256) * 1024 + head * 64, (char*)lds);
                }
#endif
            }
            grid.sync();
#if PH_MASK & 8
            {
                KPtr kp = KP(); bf16_t* PROJ = (bf16_t*)WSP(kp, WS_PROJ);
                pg8::Gemm g{PROJ + PO_Q, (const bf16_t*)WSP(kp, WS_WA) + (size_t)layer * DM * DM, PROJ + PO_HQ, (const bf16_t*)WSP(kp, WS_WH) + (size_t)layer * DM * DM, TH, DM, DM};
                pg8::TwoPassOrder S; S.S.init(TH, DM, G, c);
                EpiMerge E{PROJ + PO_MA, PROJ + PO_MH};
                pg8::gemm_phase<EpiMerge, pg8::TwoPassOrder>((LAS unsigned char*)lds, g, S, E);
            }
#endif
            grid.sync();
#if PH_MASK & 16
            {
                KPtr kp = KP(); bf16_t* PROJ = (bf16_t*)WSP(kp, WS_PROJ);
                pg8::Gemm g{PROJ + PO_MA, (const bf16_t*)WSP(kp, WS_WO) + (size_t)layer * DM * DM, nullptr, nullptr, TH, DM, DM};
                pg8::StaticOrder S; S.init(TH, DM, G, c);
                EpiResid E{(layer == 0 ? kp->x : (const float*)kp->out) + tok0 * DM, kp->out + tok0 * DM};
                pg8::gemm_phase<EpiResid, pg8::StaticOrder>((LAS unsigned char*)lds, g, S, E);
            }
#endif
            grid.sync();
        }
        if (layer + 1 < DEPTH) { IDS(); KPtr kp = KP(); rowprep(kp->out, (bf16_t*)WSP(kp, WS_XB), (float*)WSP(kp, WS_RROW), gwave, nwaves, lane); grid.sync(); }
    }
    { IDS(); KPtr kp = KP(); final_norm(kp->out, kp->fnorm_w, gwave, nwaves, lane); }
}

extern "C" void kernel_launch(void* const* d_in, const int* in_sizes, int n_in, void* d_out, int out_size, void* d_ws, size_t ws_size, hipStream_t stream) {
    static int grid_blocks = 0;
    if (grid_blocks == 0) {
        if (n_in != 11 || in_sizes[0] != NTOK * DM || out_size != NTOK * DM || ws_size < WS_END) {
            fprintf(stderr, "kernel_launch: shape mismatch (n_in %d, in0 %d, out %d, ws %zu, need %zu)\n", n_in, n_in > 0 ? in_sizes[0] : -1, out_size, ws_size, (size_t)WS_END); grid_blocks = -1; return; }
        int dev = 0, cus = 0, per_cu = 0;
        hipGetDevice(&dev); hipDeviceGetAttribute(&cus, hipDeviceAttributeMultiprocessorCount, dev);
        if (hipFuncSetAttribute((const void*)fwd_megakernel, hipFuncAttributeMaxDynamicSharedMemorySize, LDS_BYTES) != hipSuccess) { fprintf(stderr, "kernel_launch: hipFuncSetAttribute failed\n"); grid_blocks = -1; return; }
        hipOccupancyMaxActiveBlocksPerMultiprocessor(&per_cu, (const void*)fwd_megakernel, NTHREADS, LDS_BYTES);
        if (per_cu < 1) { fprintf(stderr, "kernel_launch: occupancy query says %d\n", per_cu); per_cu = 1; }
        (void)hipGetLastError();
        grid_blocks = cus;
    }
    if (grid_blocks < 0) return;
    Params p{};
    p.x = (const float*)d_in[0]; p.w_in = (const float*)d_in[1]; p.norm_w = (const float*)d_in[2]; p.q_norm_w = (const float*)d_in[3]; p.k_norm_w = (const float*)d_in[4];
    p.lbnd = (const float*)d_in[5]; p.hnorm_w = (const float*)d_in[6]; p.w_ba = (const float*)d_in[7]; p.w_bh = (const float*)d_in[8]; p.w_out = (const float*)d_in[9];
    p.fnorm_w = (const float*)d_in[10]; p.out = (float*)d_out; p.ws = (unsigned char*)d_ws;
    void* args[] = {&p};
    hipError_t e = hipLaunchCooperativeKernel((const void*)fwd_megakernel, dim3(grid_blocks), dim3(NTHREADS), args, LDS_BYTES, stream);
    if (e != hipSuccess) fprintf(stderr, "cooperative launch failed: %s (grid %d)\n", hipGetErrorString(e), grid_blocks);
}
```

```cpp
#include <hip/hip_runtime.h>
#include <hip/hip_cooperative_groups.h>
#include <cstdio>
#include <cstdint>
namespace cg = cooperative_groups;

#define LAS __attribute__((address_space(3)))
typedef unsigned short bf16_t;
typedef short bf16x8 __attribute__((ext_vector_type(8)));
typedef short s16x4 __attribute__((ext_vector_type(4)));
typedef float f32x4 __attribute__((ext_vector_type(4)));
typedef float f32x16 __attribute__((ext_vector_type(16)));
typedef unsigned u32x4 __attribute__((ext_vector_type(4)));
typedef unsigned u32x2 __attribute__((ext_vector_type(2)));

constexpr int DM = 1024, SEQ = 2048, BATCH = 32, NTOK = BATCH * SEQ, NIN = 9728, DEPTH = 2;
constexpr int HB = 16, TH = HB * SEQ;
constexpr float EPS = 1e-6f;
constexpr int NTHREADS = 512;

constexpr size_t SZ_WIN = (size_t)NIN * DM * 2, SZ_W1 = (size_t)DM * DM * 2;
constexpr size_t WS_WIN = 0, WS_WA = WS_WIN + 2 * SZ_WIN, WS_WH = WS_WA + 2 * SZ_W1, WS_WO = WS_WH + 2 * SZ_W1;
constexpr size_t WS_XB = WS_WO + 2 * SZ_W1, WS_RROW = WS_XB + (size_t)NTOK * DM * 2, WS_TAB = WS_RROW + (size_t)NTOK * 4;
constexpr int TAB_COSR = 0, TAB_SINR = 512, TAB_COSC = 1024, TAB_SINC = 2048, TAB_LB = 3072, TAB_M2 = 3072 + 2 * 2 * 1024, TAB_FLOATS = TAB_M2 + 64;
constexpr size_t WS_PROJ = (WS_TAB + TAB_FLOATS * 4 + 255) / 256 * 256;
constexpr size_t PO_Q = 0, PO_K = (size_t)TH * 1024, PO_V = (size_t)TH * 1280, PO_AG = (size_t)TH * 1536, PO_HQ = PO_AG + (size_t)TH * 1024,
                 PO_ZF = PO_HQ + (size_t)TH * 1024, PO_ZB = PO_ZF + (size_t)TH * 1024, PO_HI = PO_ZB + (size_t)TH * 1024, PO_HG = PO_HI + (size_t)TH * 1024,
                 PO_MA = PO_HG + (size_t)TH * 1024, PO_MH = PO_MA + (size_t)TH * 1024, PO_MA1 = PO_MH + (size_t)TH * 1024, PO_END = PO_MA1 + (size_t)TH * 1024;
constexpr size_t WS_END = WS_PROJ + PO_END * 2;

struct Params {
    const float* x; const float* w_in; const float* norm_w; const float* q_norm_w; const float* k_norm_w; const float* lbnd; const float* hnorm_w;
    const float* w_ba; const float* w_bh; const float* w_out; const float* fnorm_w; float* out; unsigned char* ws;
};

typedef float f32x2_t __attribute__((ext_vector_type(2))); typedef __bf16 bf16x2_t __attribute__((ext_vector_type(2)));
__device__ __forceinline__ unsigned cvt_pk_bf16(float lo, float hi) { f32x2_t v = {lo, hi}; bf16x2_t b = __builtin_convertvector(v, bf16x2_t); return __builtin_bit_cast(unsigned, b); }
__device__ __forceinline__ unsigned cvt_pk_bf16_asm(float lo, float hi) { unsigned r; asm volatile("v_cvt_pk_bf16_f32 %0, %1, %2" : "=v"(r) : "v"(lo), "v"(hi)); return r; }
__device__ __forceinline__ float bf2f(unsigned short v) { return __uint_as_float((unsigned)v << 16); }
__device__ __forceinline__ float bflo(unsigned w) { return __uint_as_float(w << 16); }
__device__ __forceinline__ float bfhi(unsigned w) { return __uint_as_float(w & 0xffff0000u); }
__device__ __forceinline__ unsigned pack_h2(float a, float b) { _Float16 ha = (_Float16)a, hb = (_Float16)b; return (unsigned)__builtin_bit_cast(unsigned short, ha) | ((unsigned)__builtin_bit_cast(unsigned short, hb) << 16); }
__device__ __forceinline__ float h2f(unsigned short v) { return (float)__builtin_bit_cast(_Float16, v); }
__device__ __forceinline__ float sigmoidf_(float x) { return __builtin_amdgcn_rcpf(1.0f + __expf(-x)); }
__device__ __forceinline__ float siluf_(float x) { return x * __builtin_amdgcn_rcpf(1.0f + __expf(-x)); }
#define LDS_BAR() do { asm volatile("s_waitcnt lgkmcnt(0)" ::: "memory"); __builtin_amdgcn_s_barrier(); asm volatile("" ::: "memory"); } while (0)

#ifdef PROBE_DUR
#define GSTAMP(k) do { if (blockIdx.x == 0 && threadIdx.x == 0) { asm volatile("s_waitcnt vmcnt(0)" ::: "memory"); const unsigned long long now_ = __builtin_amdgcn_s_memrealtime(); \
        unsigned long long* T_ = (unsigned long long*)(((const __attribute__((address_space(4))) Params*)__builtin_amdgcn_kernarg_segment_ptr())->ws + WS_END); T_[k] += now_ - T_[15]; T_[15] = now_; } } while (0)
#else
#define GSTAMP(k) do { } while (0)
#endif
namespace pg8 {
constexpr int BM = 256, BK = 64, HALF = 128, HTB = HALF * BK * 2, STAGE_BYTES = 8 * HTB, NXCD = 8, WGM = 8;
__host__ __device__ __forceinline__ int lds_byte(int r, int c) { const int st = (r >> 4) * 2 + (c >> 5), rr = r & 15, cc = c & 31, ob = rr * 64 + cc * 2; return st * 1024 + (ob ^ (((ob >> 9) & 1) << 5)); }
__host__ __device__ __forceinline__ void stage_rc(int b, int& R, int& C) { const int st = b / 1024, sb = b % 1024, swz = sb ^ (((sb >> 9) & 1) << 5); R = (st >> 1) * 16 + swz / 64; C = (st & 1) * 32 + (swz % 64) / 2; }
__host__ __device__ __forceinline__ int perm32(int rho) { const int n = rho >> 4, i = rho & 15; return 8 * (i >> 2) + 4 * n + (i & 3); }

struct Unit { int pm, pn, z; };
struct Gemm { const bf16_t* A0; const bf16_t* B0; const bf16_t* A1; const bf16_t* B1; int M, N, K; };

struct StaticOrder {
    int nM, nN, nwg, G, c;
    __device__ void init(int M, int N, int G_, int c_) { nM = M / BM; nN = N / BM; nwg = nM * nN; G = G_; c = c_; }
    __device__ bool next(int i, Unit& u) const {
        const long L = (long)i * G + c; if (L >= nwg) return false;
        int wgid = (int)L; { const int q = nwg / NXCD, r = nwg % NXCD, xcd = wgid % NXCD, off = wgid / NXCD; wgid = (xcd < r ? xcd * (q + 1) : r * (q + 1) + (xcd - r) * q) + off; }
        const int nig = WGM * nN, gid = wgid / nig, fm = gid * WGM, gsz = (nM - fm) < WGM ? (nM - fm) : WGM;
        u.pm = fm + ((wgid % nig) % gsz); u.pn = (wgid % nig) / gsz; u.z = 0; return true;
    }
};
struct TwoPassOrder {
    StaticOrder S;
    __device__ bool next(int i, Unit& u) const { if (!S.next(i >> 1, u)) return false; u.z = i & 1; return true; }
};

template <class Epi, class Sched>
__device__ __forceinline__ void gemm_phase(LAS unsigned char* lds, const Gemm g, const Sched& S, const Epi& E) {
    int tid = threadIdx.x; asm volatile("" : "+v"(tid));
    const int wid = __builtin_amdgcn_readfirstlane(tid >> 6), lane = tid & 63, wr = wid >> 2, wc = wid & 3, fr = lane & 15, fq = lane >> 4;
    const int K = g.K, nt = K / BK;
    unsigned voffA[2], voffB[2];
#pragma unroll
    for (int i = 0; i < 2; ++i) { int R, C; stage_rc(tid * 16 + i * 8192, R, C); const int Rb = Epi::PERM ? ((R & ~31) + perm32(R & 31)) : R;
        voffA[i] = (unsigned)(R * K + C) * 2u; voffB[i] = (unsigned)(Rb * K + C) * 2u; }
    const size_t kstep = (size_t)(BK * 2);
    const size_t hstep = (size_t)HALF * K * 2;
    const size_t tstep = 2 * hstep;
    const unsigned ldsw = (unsigned)wid * 1024u;
    const int aoff = lds_byte(wr * 64 + fr, fq * 8), boff = lds_byte(wc * 32 + fr, fq * 8);
#define PG8_SA(b, h) (((b) * 2 + (h)) * HTB)
#define PG8_SB(b, h) ((4 + (b) * 2 + (h)) * HTB)
#define PG8_STAGE(bufoff, gbase, voff) do { _Pragma("unroll") for (int _i = 0; _i < 2; ++_i) \
        __builtin_amdgcn_global_load_lds((const unsigned*)((const char*)(gbase) + (voff)[_i]), (LAS unsigned*)(lds + (bufoff) + ldsw + _i * 8192), 16, 0, 0); } while (0)
#define PG8_LDA(dst, b, h) do { _Pragma("unroll") for (int m = 0; m < 4; ++m) _Pragma("unroll") for (int k = 0; k < 2; ++k) dst[m][k] = *(const LAS bf16x8*)(lds + PG8_SA(b, h) + aoff + m * 2048 + k * 1024); } while (0)
#define PG8_LDB(dst, b, h) do { _Pragma("unroll") for (int n = 0; n < 2; ++n) _Pragma("unroll") for (int k = 0; k < 2; ++k) dst[n][k] = *(const LAS bf16x8*)(lds + PG8_SB(b, h) + boff + n * 2048 + k * 1024); } while (0)
#define PG8_MMA(ai, bj, At, Bt) do { __builtin_amdgcn_s_setprio(1); _Pragma("unroll") for (int m = 0; m < 4; ++m) _Pragma("unroll") for (int n = 0; n < 2; ++n) _Pragma("unroll") for (int k = 0; k < 2; ++k) \
        acc[ai][bj][m][n] = __builtin_amdgcn_mfma_f32_16x16x32_bf16(Bt[n][k], At[m][k], acc[ai][bj][m][n], 0, 0, 0); __builtin_amdgcn_s_setprio(0); } while (0)
#define PG8_WAIT_V(n) asm volatile("s_waitcnt vmcnt(" #n ")" ::: "memory")
#define PG8_WAIT_L(n) asm volatile("s_waitcnt lgkmcnt(" #n ")" ::: "memory")
#define PG8_BAR __builtin_amdgcn_s_barrier()
#define PG8_SCHED __builtin_amdgcn_sched_barrier(0)
    Unit cur, nxt; int ui = 0;
    if (!S.next(0, cur)) return;
    f32x4 acc[2][2][4][2];
#pragma unroll
    for (int a = 0; a < 2; ++a)
#pragma unroll
        for (int b = 0; b < 2; ++b)
#pragma unroll
            for (int m = 0; m < 4; ++m)
#pragma unroll
                for (int n = 0; n < 2; ++n) acc[a][b][m][n] = (f32x4){0.f, 0.f, 0.f, 0.f};
    bf16x8 At[4][2], B0[2][2], B1[2][2];
    const char* cA = (const char*)(cur.z ? g.A1 : g.A0) + (size_t)cur.pm * tstep; const char* cB = (const char*)(cur.z ? g.B1 : g.B0) + (size_t)cur.pn * tstep;
    PG8_STAGE(PG8_SB(0, 0), cB, voffB); PG8_STAGE(PG8_SB(0, 1), cB + hstep, voffB); PG8_STAGE(PG8_SA(0, 0), cA, voffA); PG8_STAGE(PG8_SA(0, 1), cA + hstep, voffA);
    if (wr == 1) PG8_BAR;
    PG8_WAIT_V(2); PG8_BAR;
    PG8_STAGE(PG8_SB(1, 0), cB + kstep, voffB); PG8_STAGE(PG8_SA(1, 0), cA + kstep, voffA); PG8_STAGE(PG8_SB(1, 1), cB + hstep + kstep, voffB);
    PG8_WAIT_V(6); PG8_BAR;
    for (;;) {
        const bool has_next = S.next(ui + 1, nxt);
        const char* nA = has_next ? (const char*)(nxt.z ? g.A1 : g.A0) + (size_t)nxt.pm * tstep : cA; const char* nB = has_next ? (const char*)(nxt.z ? g.B1 : g.B0) + (size_t)nxt.pn * tstep : cB;
        for (int t = 0; t < nt; t += 2) {
            const bool last = (t == nt - 2);
            const char* a1 = cA + (size_t)(t + 1) * kstep;
            const char* a2 = last ? nA : cA + (size_t)(t + 2) * kstep; const char* b2 = last ? nB : cB + (size_t)(t + 2) * kstep;
            const char* a3 = a2 + kstep; const char* b3 = b2 + kstep;
            PG8_LDB(B0, 0, 0); PG8_LDB(B1, 0, 1); PG8_SCHED; PG8_LDA(At, 0, 0); PG8_STAGE(PG8_SA(1, 1), a1 + hstep, voffA);
            PG8_WAIT_V(8); PG8_WAIT_L(0); PG8_BAR; PG8_MMA(0, 0, At, B0); PG8_MMA(0, 1, At, B1); PG8_BAR; PG8_SCHED;
            PG8_LDA(At, 0, 1); PG8_STAGE(PG8_SB(0, 0), b2, voffB); PG8_STAGE(PG8_SB(0, 1), b2 + hstep, voffB); PG8_STAGE(PG8_SA(0, 0), a2, voffA);
            PG8_WAIT_V(8); PG8_WAIT_L(0); PG8_BAR; PG8_MMA(1, 0, At, B0); PG8_MMA(1, 1, At, B1); PG8_BAR; PG8_SCHED;
            PG8_LDB(B0, 1, 0); PG8_LDB(B1, 1, 1); PG8_SCHED; PG8_LDA(At, 1, 0); PG8_STAGE(PG8_SA(0, 1), a2 + hstep, voffA);
            PG8_WAIT_V(8); PG8_WAIT_L(0); PG8_BAR; PG8_MMA(0, 0, At, B0); PG8_MMA(0, 1, At, B1); PG8_BAR; PG8_SCHED;
            PG8_LDA(At, 1, 1); PG8_STAGE(PG8_SB(1, 0), b3, voffB); PG8_STAGE(PG8_SB(1, 1), b3 + hstep, voffB); PG8_STAGE(PG8_SA(1, 0), a3, voffA);
            PG8_WAIT_V(8); PG8_WAIT_L(0); PG8_BAR; PG8_MMA(1, 0, At, B0); PG8_MMA(1, 1, At, B1); PG8_BAR; PG8_SCHED;
        }
        if (wr == 0) PG8_BAR;
        GSTAMP(10);
        E(acc, cur, wr, wc, fr, fq);
        GSTAMP(11);
        if (!has_next) break;
        if (!(Epi::CARRY && cur.z == 0)) {
#pragma unroll
        for (int a = 0; a < 2; ++a)
#pragma unroll
            for (int b = 0; b < 2; ++b)
#pragma unroll
                for (int m = 0; m < 4; ++m)
#pragma unroll
                    for (int n = 0; n < 2; ++n) acc[a][b][m][n] = (f32x4){0.f, 0.f, 0.f, 0.f};
        }
        cur = nxt; cA = nA; cB = nB; ++ui;
        if (wr == 1) PG8_BAR;
    }
    PG8_WAIT_V(0);
    PG8_BAR;
#undef PG8_SA
#undef PG8_SB
#undef PG8_STAGE
#undef PG8_LDA
#undef PG8_LDB
#undef PG8_MMA
#undef PG8_WAIT_V
#undef PG8_WAIT_L
#undef PG8_BAR
#undef PG8_SCHED
}
}

struct EpiProj {
    static constexpr bool PERM = true, CARRY = false;
    bf16_t* proj; const float* rrow; const float* tab; const float* qw; const float* kw; int ma_sg;
    __device__ __forceinline__ void operator()(f32x4 (&acc)[2][2][4][2], const pg8::Unit& u, int wr, int wc, int fr, int fq) const {
        const int pn = u.pn;
        if (pn < 5) {
            const float* nw = (pn < 4) ? qw : kw;
            bf16_t* base = (pn < 4) ? (proj + PO_Q + pn * 256) : (proj + PO_K);
            const int ldc = (pn < 4) ? 1024 : 256;
#pragma unroll
            for (int ai = 0; ai < 2; ++ai)
#pragma unroll
                for (int m = 0; m < 4; ++m) {
                    const int row = u.pm * 256 + ai * 128 + wr * 64 + m * 16 + fr;
                    const int s = row & (SEQ - 1), prow = s >> 6, pcol = s & 63;
                    float ss = 0.f;
#pragma unroll
                    for (int bj = 0; bj < 2; ++bj)
#pragma unroll
                        for (int n = 0; n < 2; ++n) { const f32x4 q = acc[ai][bj][m][n] * acc[ai][bj][m][n]; ss += (q[0] + q[1]) + (q[2] + q[3]); }
                    ss += __shfl_xor(ss, 16); ss += __shfl_xor(ss, 32);
                    const float sc = ((pn < 4) ? 0.18033688011112042f : 1.0f) / sqrtf(ss * (1.0f / 64.0f) + EPS);
#pragma unroll
                    for (int bj = 0; bj < 2; ++bj) {
                        const f32x4 c = *(const f32x4*)(tab + (bj ? TAB_COSC + pcol * 16 : TAB_COSR + prow * 16) + 4 * fq);
                        const f32x4 sn = *(const f32x4*)(tab + (bj ? TAB_SINC + pcol * 16 : TAB_SINR + prow * 16) + 4 * fq);
                        const f32x4 w0 = *(const f32x4*)(nw + 32 * bj + 4 * fq), w1 = *(const f32x4*)(nw + 32 * bj + 16 + 4 * fq);
                        const f32x4 x1 = acc[ai][bj][m][0] * sc * w0, x2 = acc[ai][bj][m][1] * sc * w1;
                        const f32x4 o1 = x1 * c - x2 * sn, o2 = x2 * c + x1 * sn;
                        u32x4 w; w.x = cvt_pk_bf16(o1[0], o1[1]); w.y = cvt_pk_bf16(o1[2], o1[3]); w.z = cvt_pk_bf16(o2[0], o2[1]); w.w = cvt_pk_bf16(o2[2], o2[3]);
                        *(u32x4*)(base + (size_t)row * ldc + wc * 64 + bj * 32 + 8 * fq) = w;
                    }
                    if (m & 1) asm volatile("" ::: "memory");
                }
        } else {
            bf16_t* base; int ldc = 1024; bool f16 = false;
            if (pn == 5) { base = proj + PO_V; ldc = 256; }
            else { const int sg = (pn - 6) >> 2; base = proj + PO_AG + (size_t)(sg == 6 ? ma_sg : sg) * ((size_t)TH * 1024) + ((pn - 6) & 3) * 256; f16 = (sg == 2 || sg == 3); }
            const int col0 = wc * 32 + 8 * fq; const bool hq = (pn >= 10 && pn < 14), hgs = (pn >= 26 && pn < 30);
#pragma unroll
            for (int ai = 0; ai < 2; ++ai)
#pragma unroll
                for (int m = 0; m < 4; ++m) {
                    const int row = u.pm * 256 + ai * 128 + wr * 64 + m * 16 + fr;
                    bf16_t* rowp = base + (size_t)row * ldc + col0;
#pragma unroll
                    for (int bj = 0; bj < 2; ++bj) {
                        f32x4 v0 = acc[ai][bj][m][0], v1 = acc[ai][bj][m][1]; u32x4 w;
                        if (hq) {
#pragma unroll
                            for (int e = 0; e < 4; ++e) { v0[e] = siluf_(v0[e]) * 0.08838834764831845f; v1[e] = siluf_(v1[e]) * 0.08838834764831845f; } }
                        if (hgs) {
#pragma unroll
                            for (int e = 0; e < 4; ++e) { v0[e] = siluf_(v0[e]); v1[e] = siluf_(v1[e]); } }
                        if (f16) {
#pragma unroll
                            for (int e = 0; e < 4; ++e) { v0[e] = sigmoidf_(v0[e]); v1[e] = sigmoidf_(v1[e]); } }
                        if (f16) { w.x = pack_h2(v0[0], v0[1]); w.y = pack_h2(v0[2], v0[3]); w.z = pack_h2(v1[0], v1[1]); w.w = pack_h2(v1[2], v1[3]); }
                        else { w.x = cvt_pk_bf16(v0[0], v0[1]); w.y = cvt_pk_bf16(v0[2], v0[3]); w.z = cvt_pk_bf16(v1[0], v1[1]); w.w = cvt_pk_bf16(v1[2], v1[3]); }
                        *(u32x4*)(rowp + bj * 128) = w;
                    }
                }
        }
    }
};
struct EpiMerge {
    static constexpr bool PERM = true, CARRY = true;
    bf16_t* MA; const bf16_t* MH;
    __device__ __forceinline__ void operator()(f32x4 (&acc)[2][2][4][2], const pg8::Unit& u, int wr, int wc, int fr, int fq) const {
        const int col0 = u.pn * 256 + wc * 32 + 8 * fq;
#pragma unroll
        for (int ai = 0; ai < 2; ++ai)
#pragma unroll
            for (int m = 0; m < 4; ++m) {
                const int row = u.pm * 256 + ai * 128 + wr * 64 + m * 16 + fr;
#pragma unroll
                for (int bj = 0; bj < 2; ++bj) {
                    const size_t off = (size_t)row * 1024 + col0 + bj * 128;
                    const u32x4 g = *(const u32x4*)(MH + off);
                    const unsigned gw[4] = {g.x, g.y, g.z, g.w};
                    if (u.z == 0) {
                        const u32x4 a = *(const u32x4*)(MA + off);
                        const unsigned aw[4] = {a.x, a.y, a.z, a.w};
#pragma unroll
                        for (int q = 0; q < 4; ++q) {
                            const float r0 = (1.0f + __expf(-bflo(gw[q]))) * __builtin_amdgcn_rcpf(1.0f + __expf(-bflo(aw[q])));
                            const float r1 = (1.0f + __expf(-bfhi(gw[q]))) * __builtin_amdgcn_rcpf(1.0f + __expf(-bfhi(aw[q])));
                            acc[ai][bj][m][q >> 1][2 * (q & 1)] *= r0; acc[ai][bj][m][q >> 1][2 * (q & 1) + 1] *= r1;
                        }
                    } else {
                        float r[8];
#pragma unroll
                        for (int q = 0; q < 4; ++q) { r[2 * q] = sigmoidf_(bflo(gw[q])) * acc[ai][bj][m][q >> 1][2 * (q & 1)]; r[2 * q + 1] = sigmoidf_(bfhi(gw[q])) * acc[ai][bj][m][q >> 1][2 * (q & 1) + 1]; }
                        u32x4 w; w.x = cvt_pk_bf16(r[0], r[1]); w.y = cvt_pk_bf16(r[2], r[3]); w.z = cvt_pk_bf16(r[4], r[5]); w.w = cvt_pk_bf16(r[6], r[7]);
                        *(u32x4*)(MA + off) = w;
                    }
                }
                if (m == 3) asm volatile("" ::: "memory");
            }
    }
};
struct EpiResid {
    static constexpr bool PERM = false, CARRY = false;
    const float* xin; float* out;
    __device__ __forceinline__ void operator()(f32x4 (&acc)[2][2][4][2], const pg8::Unit& u, int wr, int wc, int fr, int fq) const {
        const int col0 = u.pn * 256 + wc * 32 + 4 * fq;
#pragma unroll
        for (int ai = 0; ai < 2; ++ai)
#pragma unroll
            for (int m = 0; m < 4; ++m) {
                const size_t off = (size_t)(u.pm * 256 + ai * 128 + wr * 64 + m * 16 + fr) * 1024 + col0;
#pragma unroll
                for (int bj = 0; bj < 2; ++bj)
#pragma unroll
                    for (int n = 0; n < 2; ++n) { const f32x4 b = *(const f32x4*)(xin + off + bj * 128 + n * 16); *(f32x4*)(out + off + bj * 128 + n * 16) = b + acc[ai][bj][m][n]; }
                if (m == 3) asm volatile("" ::: "memory");
            }
    }
};

namespace att {
constexpr int QBLK = 32, KVBLK = 64, LDQ = 1024, LDK = 256;
constexpr float SCALE = 0.125f, THR = 8.f;
constexpr int SHM_V = 8192, SHM_K = 8192;
__device__ __forceinline__ int crow(int r, int hi) { return (r & 3) + 8 * (r >> 2) + 4 * hi; }
#define SBAR() __builtin_amdgcn_sched_barrier(0)
__device__ __forceinline__ void partialSM(f32x16& p0) {
#pragma unroll
    for (int r = 0; r < 16; ++r) p0[r] = __builtin_amdgcn_exp2f(p0[r]);
}
__device__ __forceinline__ void finishSM(f32x16& p0, f32x16& p1, bf16x8& pa0, bf16x8& pa1, bf16x8& pa2, bf16x8& pa3) {
#pragma unroll
    for (int r = 0; r < 16; ++r) p1[r] = __builtin_amdgcn_exp2f(p1[r]);
#define PK4(P, BASE, OUT) do { unsigned a0 = cvt_pk_bf16(P[BASE + 0], P[BASE + 1]), a1 = cvt_pk_bf16(P[BASE + 2], P[BASE + 3]);   \
    unsigned b0 = cvt_pk_bf16(P[BASE + 4], P[BASE + 5]), b1 = cvt_pk_bf16(P[BASE + 6], P[BASE + 7]);                              \
    auto r0 = __builtin_amdgcn_permlane32_swap(a0, b0, false, false); auto r1 = __builtin_amdgcn_permlane32_swap(a1, b1, false, false); \
    u32x4 w = {r0[0], r1[0], r0[1], r1[1]}; OUT = *reinterpret_cast<bf16x8*>(&w); } while (0)
    PK4(p0, 0, pa0); PK4(p0, 8, pa1); PK4(p1, 0, pa2); PK4(p1, 8, pa3);
#undef PK4
}
__device__ __forceinline__ void qkt(f32x16& p0, f32x16& p1, const char* Ks, const bf16x8* qr, const f32x16& negm, int r32, int hi) {
    p0 = negm; p1 = negm;
#pragma unroll
    for (int d0 = 0; d0 < 4; ++d0) {
        const bf16x8 b0 = *reinterpret_cast<const bf16x8*>(Ks + (2 * d0 + hi) * 1024 + r32 * 16);
        const bf16x8 b1 = *reinterpret_cast<const bf16x8*>(Ks + (2 * d0 + hi) * 1024 + 512 + r32 * 16);
        p0 = __builtin_amdgcn_mfma_f32_32x32x16_bf16(b0, qr[d0], p0, 0, 0, 0);
        p1 = __builtin_amdgcn_mfma_f32_32x32x16_bf16(b1, qr[d0], p1, 0, 0, 0); }
}
__device__ __forceinline__ int v_st(int k, int c) { const int kk = (k & ~0xC) | ((k & 4) << 1) | ((k & 8) >> 1); return ((kk >> 3) * 2 + (c >> 5)) * 512 + ((kk & 7) * 32 + (c & 31)) * 2; }
__device__ __forceinline__ int v_rd_base(int lane) { return ((lane & 3) << 3) | (((lane >> 2) & 3) << 6) | (((lane >> 4) & 1) << 5) | (((lane >> 5) & 1) << 8); }
constexpr int v_rd_off(int d0, int ks, int half) { return d0 * 512 + ks * 2048 + half * 1024; }
template <int OFF> __device__ __forceinline__ s16x4 tr_read(int vb) { s16x4 r; asm volatile("ds_read_b64_tr_b16 %0, %1 offset:%2" : "=&v"(r) : "v"(vb), "i"(OFF) : "memory"); return r; }
template <int D0> __device__ __forceinline__ void pv_one(f32x16& od, int vb, bf16x8 pa0, bf16x8 pa1, bf16x8 pa2, bf16x8 pa3) {
    const s16x4 l0 = tr_read<v_rd_off(D0, 0, 0)>(vb), h0 = tr_read<v_rd_off(D0, 0, 1)>(vb), l1 = tr_read<v_rd_off(D0, 1, 0)>(vb), h1 = tr_read<v_rd_off(D0, 1, 1)>(vb);
    const s16x4 l2 = tr_read<v_rd_off(D0, 2, 0)>(vb), h2 = tr_read<v_rd_off(D0, 2, 1)>(vb), l3 = tr_read<v_rd_off(D0, 3, 0)>(vb), h3 = tr_read<v_rd_off(D0, 3, 1)>(vb);
    asm volatile("s_waitcnt lgkmcnt(0)" ::: "memory"); SBAR();
#define PK(L, H) (bf16x8){L[0], L[1], L[2], L[3], H[0], H[1], H[2], H[3]}
    od = __builtin_amdgcn_mfma_f32_32x32x16_bf16(pa0, PK(l0, h0), od, 0, 0, 0);
    od = __builtin_amdgcn_mfma_f32_32x32x16_bf16(pa1, PK(l1, h1), od, 0, 0, 0);
    od = __builtin_amdgcn_mfma_f32_32x32x16_bf16(pa2, PK(l2, h2), od, 0, 0, 0);
    od = __builtin_amdgcn_mfma_f32_32x32x16_bf16(pa3, PK(l3, h3), od, 0, 0, 0);
#undef PK
}
__device__ __forceinline__ void pv_d0(f32x16* o, f32x16& lacc, int vb, bf16x8 pa0, bf16x8 pa1, bf16x8 pa2, bf16x8 pa3) {
    const bf16x8 ones = (bf16x8){0x3F80, 0x3F80, 0x3F80, 0x3F80, 0x3F80, 0x3F80, 0x3F80, 0x3F80};
    pv_one<0>(o[0], vb, pa0, pa1, pa2, pa3);
    lacc = __builtin_amdgcn_mfma_f32_32x32x16_bf16(pa0, ones, lacc, 0, 0, 0);
    lacc = __builtin_amdgcn_mfma_f32_32x32x16_bf16(pa1, ones, lacc, 0, 0, 0);
    pv_one<1>(o[1], vb, pa0, pa1, pa2, pa3);
    lacc = __builtin_amdgcn_mfma_f32_32x32x16_bf16(pa2, ones, lacc, 0, 0, 0);
    lacc = __builtin_amdgcn_mfma_f32_32x32x16_bf16(pa3, ones, lacc, 0, 0, 0);
}

__device__ __forceinline__ void attn_unit(bf16_t* Qb, const bf16_t* __restrict__ Kh, const bf16_t* __restrict__ Vh, const bf16_t* __restrict__ Gb, float m2, char* lds) {
    int tid = threadIdx.x; asm volatile("" : "+v"(tid));
    const int wid = tid >> 6, lane = tid & 63, r32 = lane & 31, hi = lane >> 5;
    char* V_lds = lds; char* K_lds = lds + 3 * SHM_V;
    float* ws = (float*)(lds + 3 * SHM_V + 3 * SHM_K) + wid * 64; float* li_l = ws;
    f32x16 lacc = {}; f32x16 o[2] = {}; bf16x8 qr[4];
    f32x16 negm;
#pragma unroll
    for (int r = 0; r < 16; ++r) negm[r] = -m2;
    const bf16_t* Qw = Qb + (size_t)(wid * QBLK + r32) * LDQ + hi * 8;
#pragma unroll
    for (int d0 = 0; d0 < 4; ++d0) qr[d0] = *reinterpret_cast<const bf16x8*>(Qw + d0 * 16);
    const int krow = tid & 63, kch = tid >> 6, kst = kch * 1024 + krow * 16;
    const int sr = tid >> 3, sc = (tid & 7) * 8, vst0 = v_st(sr, sc);
    const int vb0 = (int)(uintptr_t)V_lds + v_rd_base(lane);
    bf16x8 svA, skA, svB, skB;
#define SLOADA(k0) do { svA = *reinterpret_cast<const bf16x8*>(&Vh[(size_t)((k0) + sr) * LDK + sc]); skA = *reinterpret_cast<const bf16x8*>(&Kh[(size_t)((k0) + krow) * LDK + kch * 8]); } while (0)
#define SLOADB(k0) do { svB = *reinterpret_cast<const bf16x8*>(&Vh[(size_t)((k0) + sr) * LDK + sc]); skB = *reinterpret_cast<const bf16x8*>(&Kh[(size_t)((k0) + krow) * LDK + kch * 8]); } while (0)
#define SWRITEA(bo) do { *(bf16x8*)(V_lds + (bo) + vst0) = svA; *(bf16x8*)(K_lds + (bo) + kst) = skA; } while (0)
#define SWRITEB(bo) do { *(bf16x8*)(V_lds + (bo) + vst0) = svB; *(bf16x8*)(K_lds + (bo) + kst) = skB; } while (0)
    f32x16 pA0, pA1, pB0, pB1; bf16x8 pa0, pa1, pa2, pa3; constexpr int NT = SEQ / KVBLK;
    static_assert(SHM_V == SHM_K, "one rotating offset serves both rings");
    SLOADA(0); SLOADB(KVBLK); asm volatile("s_waitcnt vmcnt(2)" ::: "memory"); SWRITEA(0); SLOADA(2 * KVBLK); __syncthreads();
    SWRITEB(SHM_V); SLOADB(3 * KVBLK);
    qkt(pA0, pA1, K_lds, qr, negm, r32, hi); partialSM(pA0);
    __syncthreads();
    int bp = 0, bc = SHM_V, bn = 2 * SHM_V;
#define ROT3() do { const int t_ = bp; bp = bc; bc = bn; bn = t_; } while (0)
#define STEP_ODD(j) do { \
        SBAR(); qkt(pB0, pB1, K_lds + bc, qr, negm, r32, hi); \
        finishSM(pA0, pA1, pa0, pa1, pa2, pa3); SBAR(); \
        if ((j) + 1 < NT) SWRITEA(bn); \
        if ((j) + 3 < NT) SLOADA(((j) + 3) * KVBLK); SBAR(); \
        pv_d0(o, lacc, vb0 + bp, pa0, pa1, pa2, pa3); partialSM(pB0); \
        __syncthreads(); ROT3(); } while (0)
#define STEP_EVEN(j) do { \
        SBAR(); qkt(pA0, pA1, K_lds + bc, qr, negm, r32, hi); \
        finishSM(pB0, pB1, pa0, pa1, pa2, pa3); SBAR(); \
        if ((j) + 1 < NT) SWRITEB(bn); \
        if ((j) + 3 < NT) SLOADB(((j) + 3) * KVBLK); SBAR(); \
        pv_d0(o, lacc, vb0 + bp, pa0, pa1, pa2, pa3); partialSM(pA0); \
        __syncthreads(); ROT3(); } while (0)
    for (int j = 1; j + 1 < NT; j += 2) { STEP_ODD(j); STEP_EVEN(j + 1); }
    STEP_ODD(NT - 1);
    finishSM(pB0, pB1, pa0, pa1, pa2, pa3); SBAR();
    pv_d0(o, lacc, vb0 + bp, pa0, pa1, pa2, pa3);
#undef STEP_ODD
#undef STEP_EVEN
#undef ROT3
    float rli[16];
#pragma unroll
    for (int r = 0; r < 16; ++r) rli[r] = __builtin_amdgcn_rcpf(lacc[r]);
    __syncthreads();
    bf16_t* stg = (bf16_t*)lds + wid * 2048;
#pragma unroll
    for (int r = 0; r < 16; ++r) { const int orow = crow(r, hi);
#pragma unroll
        for (int d0 = 0; d0 < 2; ++d0) stg[orow * 64 + d0 * 32 + r32] = (bf16_t)(cvt_pk_bf16(o[d0][r] * rli[r], 0.f) & 0xffffu); }
    asm volatile("s_waitcnt lgkmcnt(0)" ::: "memory");
#pragma unroll
    for (int i = 0; i < 4; ++i) {
        const int row = i * 8 + (lane >> 3), ch = lane & 7;
        const u32x4 v = *(const u32x4*)(stg + row * 64 + ch * 8);
        const size_t goff = (size_t)(wid * QBLK + row) * LDQ + ch * 8;
        const u32x4 g = *(const u32x4*)(Gb + goff);
        u32x4 w;
        w.x = cvt_pk_bf16(bflo(v.x) * siluf_(bflo(g.x)), bfhi(v.x) * siluf_(bfhi(g.x))); w.y = cvt_pk_bf16(bflo(v.y) * siluf_(bflo(g.y)), bfhi(v.y) * siluf_(bfhi(g.y)));
        w.z = cvt_pk_bf16(bflo(v.z) * siluf_(bflo(g.z)), bfhi(v.z) * siluf_(bfhi(g.z))); w.w = cvt_pk_bf16(bflo(v.w) * siluf_(bflo(g.w)), bfhi(v.w) * siluf_(bfhi(g.w)));
        *(u32x4*)(Qb + goff) = w;
    }
    __syncthreads();
#undef SLOADA
#undef SLOADB
#undef SWRITEA
#undef SWRITEB
#undef SWAIT
}
}

namespace hg {
constexpr int QRAW = 0, ZRAW = 8192, VRAW = 16384, QT = 24576, KT = QT + 8704, KDT = KT + 8704, DL = KDT + 10240, TOT = DL + 512, OT = TOT + 1024, GROUP_BYTES = OT + 16384;
constexpr int NC = SEQ / 32;
__device__ __forceinline__ int crow(int r, int hi) { return (r & 3) + 8 * (r >> 2) + 4 * hi; }
__device__ __forceinline__ void hgrn_item(char* lds, bf16_t* proj, int bl, int h, const float* lb0, const float* lb1, const float* gw) {
    int tid = threadIdx.x; asm volatile("" : "+v"(tid));
    const int gd = __builtin_amdgcn_readfirstlane(tid >> 8), wv = __builtin_amdgcn_readfirstlane((tid >> 6) & 3);
    const int gt = tid & 255, lane = tid & 63, r32 = lane & 31, hi = lane >> 5;
    char* G = lds + gd * GROUP_BYTES;
    const size_t hb = (size_t)bl * SEQ * 1024 + h * 128;
    bf16_t* HQp = proj + PO_HQ + hb;
    const bf16_t* Zp = proj + (gd ? PO_ZB : PO_ZF) + hb;
    bf16_t* PW = proj + (gd ? PO_ZB : PO_ZF) + hb;
    const bf16_t* PR = proj + (gd ? PO_ZF : PO_ZB) + hb;
    const bf16_t* HIp = proj + PO_HI + hb; const bf16_t* HGp = proj + PO_HG + hb;
    const int k0 = 2 * lane, tg = wv;
    const float lbA = (gd ? lb1 : lb0)[h * 128 + k0], lbB = (gd ? lb1 : lb0)[h * 128 + k0 + 1], omA = 1.0f - lbA, omB = 1.0f - lbB;
    f32x16 sacc[4];
#pragma unroll
    for (int i = 0; i < 4; ++i) sacc[i] = f32x16{};
    unsigned zr[8], qq8[8]; u32x4 pv[2];
    const int prow0 = gt >> 4, pc8 = (gt & 15) * 8;
    const int rfirst = gd ? 31 - 8 * tg : 8 * tg, rstep = gd ? -1 : 1;
#define HG_LOADZ(dst, c) do { _Pragma("unroll") for (int j = 0; j < 8; ++j) dst[j] = *(const unsigned*)(Zp + (size_t)((c) * 32 + rfirst + j * rstep) * 1024 + k0); } while (0)
#define HG_LOAD(dq, dv, c) do { _Pragma("unroll") for (int j = 0; j < 8; ++j) { const size_t go = (size_t)((c) * 32 + rfirst + j * rstep) * 1024 + k0; \
        dq[j] = *(const unsigned*)(HQp + go); } \
        _Pragma("unroll") for (int ii = 0; ii < 2; ++ii) dv[ii] = *(const u32x4*)(HIp + (size_t)((c) * 32 + prow0 + 16 * ii) * 1024 + pc8); } while (0)
    HG_LOADZ(zr, gd ? NC - 1 : 0); HG_LOAD(qq8, pv, gd ? NC - 1 : 0);
    const int i16 = r32 & 15, g16 = r32 >> 4;
    const int vtr = (int)(uintptr_t)(G + VRAW) + (gd ? (7 - 4 * hi - (i16 >> 2)) : (4 * hi + (i16 >> 2))) * 256 + (32 * wv + 16 * g16 + 4 * (i16 & 3)) * 2;
    const int ktr = (int)(uintptr_t)(G + KT) + (4 * hi + (i16 >> 2)) * 272 + (16 * g16 + 4 * (i16 & 3)) * 2;
    const int et = gt >> 3, ec16 = (gt & 7) * 16;
    float gwr[16];
#pragma unroll
    for (int j = 0; j < 16; ++j) gwr[j] = gw[ec16 + j];
    size_t ego = 0; unsigned long long pw[4] = {0, 0, 0, 0}; u32x4 g0 = {0, 0, 0, 0}, g1 = {0, 0, 0, 0};
    float feA[8], feB[8], PlA[8], PlB[8];
    f32x16 mk;
#pragma unroll
    for (int r = 0; r < 16; ++r) mk[r] = (crow(r, hi) <= r32) ? 1.0f : 0.0f;
    for (int i = 0; i <= NC; ++i) {
        if (i > 0) {
            float ov[16];
#pragma unroll
            for (int q4 = 0; q4 < 4; ++q4) { const f32x4 v = *(const f32x4*)(G + OT + (et * 128 + ec16 + 4 * q4) * 4); ov[4 * q4] = v[0]; ov[4 * q4 + 1] = v[1]; ov[4 * q4 + 2] = v[2]; ov[4 * q4 + 3] = v[3]; }
            if (i - 1 < NC / 2) {
                u32x4 w0, w1;
                w0.x = cvt_pk_bf16(ov[0], ov[1]); w0.y = cvt_pk_bf16(ov[2], ov[3]); w0.z = cvt_pk_bf16(ov[4], ov[5]); w0.w = cvt_pk_bf16(ov[6], ov[7]);
                w1.x = cvt_pk_bf16(ov[8], ov[9]); w1.y = cvt_pk_bf16(ov[10], ov[11]); w1.z = cvt_pk_bf16(ov[12], ov[13]); w1.w = cvt_pk_bf16(ov[14], ov[15]);
                *(u32x4*)(PW + ego) = w0; *(u32x4*)(PW + ego + 8) = w1;
                if (i == NC / 2) asm volatile("s_waitcnt vmcnt(0)" ::: "memory");
            } else {
                float ss = 0.f;
#pragma unroll
                for (int q4 = 0; q4 < 4; ++q4) { const unsigned lo = (unsigned)pw[q4], hi2 = (unsigned)(pw[q4] >> 32);
                    ov[4 * q4] += bflo(lo); ov[4 * q4 + 1] += bfhi(lo); ov[4 * q4 + 2] += bflo(hi2); ov[4 * q4 + 3] += bfhi(hi2); }
#pragma unroll
                for (int j = 0; j < 16; ++j) ss += ov[j] * ov[j];
                ss += __shfl_xor(ss, 1); ss += __shfl_xor(ss, 2); ss += __shfl_xor(ss, 4);
                const float rstd = __builtin_amdgcn_rsqf(ss * (1.0f / 128.0f) + EPS);
                const unsigned gg[8] = {g0.x, g0.y, g0.z, g0.w, g1.x, g1.y, g1.z, g1.w};
                unsigned wo[8];
#pragma unroll
                for (int j = 0; j < 8; ++j) { const float a = ov[2 * j] * rstd * gwr[2 * j] * bflo(gg[j]), b = ov[2 * j + 1] * rstd * gwr[2 * j + 1] * bfhi(gg[j]); wo[j] = cvt_pk_bf16(a, b); }
                *(u32x4*)(HQp + ego) = (u32x4){wo[0], wo[1], wo[2], wo[3]}; *(u32x4*)(HQp + ego + 8) = (u32x4){wo[4], wo[5], wo[6], wo[7]};
            }
        }
        if (i == NC) break;
        const int c = gd ? NC - 1 - i : i;
        {
            float PA = 1.0f, PB = 1.0f;
#pragma unroll
            for (int j = 0; j < 8; ++j) {
                const float sA = h2f((unsigned short)(zr[j] & 0xffffu)), sB = h2f((unsigned short)(zr[j] >> 16));
                PA *= lbA + omA * sA; PB *= lbB + omB * sB; PlA[j] = PA; PlB[j] = PB; feA[j] = omA - omA * sA; feB[j] = omB - omB * sB; }
            *(float2*)(G + TOT + (tg * 128 + k0) * 4) = make_float2(PA, PB);
            if (i + 1 < NC) { const int c1 = gd ? c - 1 : c + 1; HG_LOADZ(zr, c1); }
        }
        LDS_BAR();
        {
            float preA = 1.0f, preB = 1.0f, plA = 1.0f, plB = 1.0f;
#pragma unroll
            for (int g4 = 0; g4 < 4; ++g4) { const float2 tt = *(const float2*)(G + TOT + (g4 * 128 + k0) * 4); plA *= tt.x; plB *= tt.y; if (g4 < tg) { preA *= tt.x; preB *= tt.y; } }
#pragma unroll
            for (int j = 0; j < 8; ++j) { const int t = 8 * tg + j;
                const float PtA = preA * PlA[j], PtB = preB * PlB[j];
                const float ktA = feA[j] * __builtin_amdgcn_rcpf(fmaxf(PtA, 1e-30f)), ktB = feB[j] * __builtin_amdgcn_rcpf(fmaxf(PtB, 1e-30f));
                *(unsigned*)(G + QT + t * 272 + k0 * 2) = cvt_pk_bf16(bflo(qq8[j]) * PtA, bfhi(qq8[j]) * PtB);
                *(unsigned*)(G + KT + t * 272 + k0 * 2) = cvt_pk_bf16(ktA, ktB);
            }
            if (tg == 0) *(float2*)(G + DL + k0 * 4) = make_float2(plA, plB);
#pragma unroll
            for (int ii = 0; ii < 2; ++ii) *(u32x4*)(G + VRAW + (prow0 + 16 * ii) * 256 + pc8 * 2) = pv[ii];
            ego = (size_t)(c * 32 + (gd ? 31 - et : et)) * 1024 + ec16;
            if (i >= NC / 2) {
                const unsigned long long* pp = (const unsigned long long*)(PR + ego);
#pragma unroll
                for (int q4 = 0; q4 < 4; ++q4) pw[q4] = __hip_atomic_load(pp + q4, __ATOMIC_RELAXED, __HIP_MEMORY_SCOPE_AGENT);
                g0 = *(const u32x4*)(HGp + ego); g1 = *(const u32x4*)(HGp + ego + 8);
            }
            if (i + 1 < NC) { const int c1 = gd ? c - 1 : c + 1; HG_LOAD(qq8, pv, c1); }
        }
        LDS_BAR();
        {
            s16x4 v00, v01, v10, v11;
            if (gd == 0) {
                asm volatile("ds_read_b64_tr_b16 %0, %1 offset:0" : "=&v"(v00) : "v"(vtr) : "memory"); asm volatile("ds_read_b64_tr_b16 %0, %1 offset:2048" : "=&v"(v01) : "v"(vtr) : "memory");
                asm volatile("ds_read_b64_tr_b16 %0, %1 offset:4096" : "=&v"(v10) : "v"(vtr) : "memory"); asm volatile("ds_read_b64_tr_b16 %0, %1 offset:6144" : "=&v"(v11) : "v"(vtr) : "memory");
            } else {
                asm volatile("ds_read_b64_tr_b16 %0, %1 offset:6144" : "=&v"(v00) : "v"(vtr) : "memory"); asm volatile("ds_read_b64_tr_b16 %0, %1 offset:4096" : "=&v"(v01) : "v"(vtr) : "memory");
                asm volatile("ds_read_b64_tr_b16 %0, %1 offset:2048" : "=&v"(v10) : "v"(vtr) : "memory"); asm volatile("ds_read_b64_tr_b16 %0, %1 offset:0" : "=&v"(v11) : "v"(vtr) : "memory");
            }
            f32x16 X = f32x16{};
#pragma unroll
            for (int ks = 0; ks < 8; ++ks) {
                const bf16x8 a = *(const bf16x8*)(G + KT + r32 * 272 + (16 * ks + 8 * hi) * 2);
                const bf16x8 b = *(const bf16x8*)(G + QT + r32 * 272 + (16 * ks + 8 * hi) * 2);
                X = __builtin_amdgcn_mfma_f32_32x32x16_bf16(a, b, X, 0, 0, 0);
            }
            X = X * mk;
            asm volatile("s_waitcnt lgkmcnt(0)" : "+v"(v00), "+v"(v01), "+v"(v10), "+v"(v11) :: "memory");
            bf16x8 pa[2], vb[2];
            vb[0] = (bf16x8){v00[0], v00[1], v00[2], v00[3], v01[0], v01[1], v01[2], v01[3]};
            vb[1] = (bf16x8){v10[0], v10[1], v10[2], v10[3], v11[0], v11[1], v11[2], v11[3]};
#pragma unroll
            for (int sp = 0; sp < 2; ++sp) {
                u32x4 w; w.x = cvt_pk_bf16(X[8 * sp + 0], X[8 * sp + 1]); w.y = cvt_pk_bf16(X[8 * sp + 2], X[8 * sp + 3]); w.z = cvt_pk_bf16(X[8 * sp + 4], X[8 * sp + 5]); w.w = cvt_pk_bf16(X[8 * sp + 6], X[8 * sp + 7]);
                pa[sp] = __builtin_bit_cast(bf16x8, w);
            }
            f32x16 oacc = f32x16{};
            oacc = __builtin_amdgcn_mfma_f32_32x32x16_bf16(pa[0], vb[0], oacc, 0, 0, 0);
            oacc = __builtin_amdgcn_mfma_f32_32x32x16_bf16(pa[1], vb[1], oacc, 0, 0, 0);
#pragma unroll
            for (int kt = 0; kt < 4; ++kt) {
#pragma unroll
                for (int sp = 0; sp < 2; ++sp) {
                    u32x4 w; w.x = cvt_pk_bf16(sacc[kt][8 * sp + 0], sacc[kt][8 * sp + 1]); w.y = cvt_pk_bf16(sacc[kt][8 * sp + 2], sacc[kt][8 * sp + 3]);
                    w.z = cvt_pk_bf16(sacc[kt][8 * sp + 4], sacc[kt][8 * sp + 5]); w.w = cvt_pk_bf16(sacc[kt][8 * sp + 6], sacc[kt][8 * sp + 7]);
                    const bf16x8 sb = __builtin_bit_cast(bf16x8, w);
                    const s16x4 lo = *(const s16x4*)(G + QT + r32 * 272 + (32 * kt + 16 * sp + 4 * hi) * 2);
                    const s16x4 h4 = *(const s16x4*)(G + QT + r32 * 272 + (32 * kt + 16 * sp + 8 + 4 * hi) * 2);
                    const bf16x8 qa = (bf16x8){lo[0], lo[1], lo[2], lo[3], h4[0], h4[1], h4[2], h4[3]};
                    oacc = __builtin_amdgcn_mfma_f32_32x32x16_bf16(qa, sb, oacc, 0, 0, 0);
                }
            }
#pragma unroll
            for (int kh = 0; kh < 2; ++kh) {
                s16x4 kf[2][2][2];
#pragma unroll
                for (int k2 = 0; k2 < 2; ++k2)
#pragma unroll
                    for (int sp = 0; sp < 2; ++sp)
#pragma unroll
                        for (int pp2 = 0; pp2 < 2; ++pp2) asm volatile("ds_read_b64_tr_b16 %0, %1 offset:%2" : "=&v"(kf[k2][sp][pp2]) : "v"(ktr), "i"(sp * 4352 + pp2 * 2176 + (2 * kh + k2) * 64) : "memory");
                asm volatile("s_waitcnt lgkmcnt(0)" : "+v"(kf[0][0][0]), "+v"(kf[0][0][1]), "+v"(kf[0][1][0]), "+v"(kf[0][1][1]), "+v"(kf[1][0][0]), "+v"(kf[1][0][1]), "+v"(kf[1][1][0]), "+v"(kf[1][1][1]) :: "memory");
#pragma unroll
                for (int k2 = 0; k2 < 2; ++k2) {
                    const int kt = 2 * kh + k2;
#pragma unroll
                    for (int sp = 0; sp < 2; ++sp) {
                        const bf16x8 ka = (bf16x8){kf[k2][sp][0][0], kf[k2][sp][0][1], kf[k2][sp][0][2], kf[k2][sp][0][3], kf[k2][sp][1][0], kf[k2][sp][1][1], kf[k2][sp][1][2], kf[k2][sp][1][3]};
                        sacc[kt] = __builtin_amdgcn_mfma_f32_32x32x16_bf16(ka, vb[sp], sacc[kt], 0, 0, 0);
                    }
#pragma unroll
                    for (int rq = 0; rq < 4; ++rq) { const f32x4 d4 = *(const f32x4*)(G + DL + (32 * kt + 8 * rq + 4 * hi) * 4);
                        sacc[kt][4 * rq + 0] *= d4[0]; sacc[kt][4 * rq + 1] *= d4[1]; sacc[kt][4 * rq + 2] *= d4[2]; sacc[kt][4 * rq + 3] *= d4[3]; }
                }
            }
#pragma unroll
            for (int r = 0; r < 16; ++r) ((float*)(G + OT))[crow(r, hi) * 128 + 32 * wv + r32] = oacc[r];
        }
        LDS_BAR();
    }
#undef HG_LOAD
#undef HG_LOADZ
}
}

__device__ __forceinline__ void transpose_w(const float* __restrict__ W, int K, int N, bf16_t* __restrict__ out, const float* __restrict__ ksc, bool permqk, float* tile  ) {
    const int tid = threadIdx.x, ntn = N / 64, ntk = K / 64, ntiles = ntn * ntk;
    const int lk = tid >> 3, lc = (tid & 7) * 8;
    for (int t = blockIdx.x; t < ntiles; t += gridDim.x) {
        const int n0 = (t % ntn) * 64, k0 = (t / ntn) * 64;
        const float sc = ksc ? ksc[k0 + lk] : 1.0f;
        float v[8];
#pragma unroll
        for (int j = 0; j < 8; ++j) {
            const int nv = n0 + lc + j; int nr = nv;
            if (permqk && nv < 1280) { const int cv = nv & 255; const int bj = cv >> 7, wc = (cv >> 5) & 3, fq = (cv >> 3) & 3, n = (cv >> 2) & 1, e = cv & 3; nr = (nv & ~255) + 64 * wc + 32 * bj + 16 * n + 4 * fq + e; }
            v[j] = W[(size_t)(k0 + lk) * N + nr] * sc;
        }
#pragma unroll
        for (int j = 0; j < 8; ++j) tile[(lc + j) * 65 + lk] = v[j];
        __syncthreads();
        const float* tr = tile + lk * 65 + lc;
        u32x4 w; w.x = cvt_pk_bf16(tr[0], tr[1]); w.y = cvt_pk_bf16(tr[2], tr[3]); w.z = cvt_pk_bf16(tr[4], tr[5]); w.w = cvt_pk_bf16(tr[6], tr[7]);
        *(u32x4*)(out + (size_t)(n0 + lk) * K + k0 + lc) = w;
        __syncthreads();
    }
}
__device__ __forceinline__ void rowprep(const float* __restrict__ x, bf16_t* __restrict__ xb, float* __restrict__ rrow, int gwave, int nwaves, int lane) {
    for (int row0 = gwave; row0 < NTOK; row0 += 2 * nwaves) {
        const int row1 = row0 + nwaves; const bool has1 = row1 < NTOK;
        const float* xr0 = x + (size_t)row0 * DM; const float* xr1 = x + (size_t)(has1 ? row1 : row0) * DM;
        float s0 = 0.f, s1 = 0.f; f32x4 v0[4], v1[4];
#pragma unroll
        for (int i = 0; i < 4; ++i) { v0[i] = *(const f32x4*)(xr0 + 4 * lane + 256 * i); v1[i] = *(const f32x4*)(xr1 + 4 * lane + 256 * i); }
#pragma unroll
        for (int i = 0; i < 4; ++i) { const f32x4 q0 = v0[i] * v0[i], q1 = v1[i] * v1[i]; s0 += (q0[0] + q0[1]) + (q0[2] + q0[3]); s1 += (q1[0] + q1[1]) + (q1[2] + q1[3]); }
#pragma unroll
        for (int o = 1; o < 64; o <<= 1) { s0 += __shfl_xor(s0, o); s1 += __shfl_xor(s1, o); }
        const float r0 = __builtin_amdgcn_rsqf(s0 * (1.0f / DM) + EPS), r1 = __builtin_amdgcn_rsqf(s1 * (1.0f / DM) + EPS);
#pragma unroll
        for (int i = 0; i < 4; ++i) { u32x2 w; w.x = cvt_pk_bf16(v0[i][0] * r0, v0[i][1] * r0); w.y = cvt_pk_bf16(v0[i][2] * r0, v0[i][3] * r0); *(u32x2*)(xb + (size_t)row0 * DM + 4 * lane + 256 * i) = w; }
        if (has1) {
#pragma unroll
            for (int i = 0; i < 4; ++i) { u32x2 w; w.x = cvt_pk_bf16(v1[i][0] * r1, v1[i][1] * r1); w.y = cvt_pk_bf16(v1[i][2] * r1, v1[i][3] * r1); *(u32x2*)(xb + (size_t)row1 * DM + 4 * lane + 256 * i) = w; }
        }
    }
}
__device__ __forceinline__ void final_norm(float* __restrict__ x, const float* __restrict__ fw, int gwave, int nwaves, int lane) {
    f32x4 w4[4];
#pragma unroll
    for (int i = 0; i < 4; ++i) w4[i] = *(const f32x4*)(fw + 4 * lane + 256 * i);
    for (int row0 = gwave; row0 < NTOK; row0 += 2 * nwaves) {
        const int row1 = row0 + nwaves; const bool has1 = row1 < NTOK;
        float* xr0 = x + (size_t)row0 * DM; float* xr1 = x + (size_t)(has1 ? row1 : row0) * DM;
        float s0 = 0.f, s1 = 0.f; f32x4 v0[4], v1[4];
#pragma unroll
        for (int i = 0; i < 4; ++i) { v0[i] = *(const f32x4*)(xr0 + 4 * lane + 256 * i); v1[i] = *(const f32x4*)(xr1 + 4 * lane + 256 * i); }
#pragma unroll
        for (int i = 0; i < 4; ++i) { const f32x4 q0 = v0[i] * v0[i], q1 = v1[i] * v1[i]; s0 += (q0[0] + q0[1]) + (q0[2] + q0[3]); s1 += (q1[0] + q1[1]) + (q1[2] + q1[3]); }
#pragma unroll
        for (int o = 1; o < 64; o <<= 1) { s0 += __shfl_xor(s0, o); s1 += __shfl_xor(s1, o); }
        const float r0 = 1.0f / sqrtf(s0 * (1.0f / DM) + EPS), r1 = 1.0f / sqrtf(s1 * (1.0f / DM) + EPS);
#pragma unroll
        for (int i = 0; i < 4; ++i) __builtin_nontemporal_store(v0[i] * r0 * w4[i], (f32x4*)(xr0 + 4 * lane + 256 * i));
        if (has1) {
#pragma unroll
            for (int i = 0; i < 4; ++i) __builtin_nontemporal_store(v1[i] * r1 * w4[i], (f32x4*)(xr1 + 4 * lane + 256 * i));
        }
    }
}

#define XB_TMO      128
#define XB_XCNT(j)  (256  + 64 * (j))
#define XB_XSUB(j)  (1280 + 64 * (j))
#define XB_XGEN(j)  (2304 + 64 * (j))
#define XB_TOP      3328
#define XB_TOPGEN   3392
#define XCD_BAR_WORDS 3456
#define XB_SPIN_CAP (1u << 18)
__device__ __forceinline__ unsigned xb_ld(unsigned* p)              { return __hip_atomic_load(p, __ATOMIC_RELAXED, __HIP_MEMORY_SCOPE_AGENT); }
__device__ __forceinline__ unsigned xb_add(unsigned* p, unsigned v) { return __hip_atomic_fetch_add(p, v, __ATOMIC_RELAXED, __HIP_MEMORY_SCOPE_AGENT); }
__device__ __forceinline__ unsigned xb_xcc_id() { return (unsigned)__builtin_amdgcn_s_getreg((3 << 11) | 20) & 0xFu; }
#define XB_SPIN(cond, bar) do { unsigned _sp = 0; while (cond) { __builtin_amdgcn_s_sleep(1); \
    if ((++_sp & 255u) == 0u) { if (xb_ld(&(bar)[XB_TMO])) break; if (_sp > XB_SPIN_CAP) { atomicAdd(&(bar)[XB_TMO], 1u); break; } } } } while (0)
struct XcdBarrier { unsigned* bar; unsigned x; volatile LAS unsigned* st; };
__device__ __forceinline__ void xcd_barrier_post(unsigned* bar) { if (threadIdx.x == 0) (void)xb_add(&bar[XB_XCNT(xb_xcc_id())], 1u); }
__device__ __forceinline__ void xcd_barrier_complete(unsigned* bar, unsigned x, unsigned& nloc, unsigned& nx) {
    const unsigned G = gridDim.x * gridDim.y * gridDim.z;
    unsigned sum, cnt, mine, sp = 0u;
    for (;;) {
        sum = 0u; cnt = 0u; mine = 0u;
#pragma unroll
        for (unsigned j = 0; j < 16; ++j) { const unsigned c = xb_ld(&bar[XB_XCNT(j)]); sum += c; cnt += (c > 0u) ? 1u : 0u; mine = (j == x) ? c : mine; }
        if (sum == G) break;
        __builtin_amdgcn_s_sleep(1);
        if ((++sp & 255u) == 0u) { if (xb_ld(&bar[XB_TMO])) break; if (sp > XB_SPIN_CAP) { atomicAdd(&bar[XB_TMO], 1u); break; } }
    }
    nloc = mine > 0u ? mine : 1u; nx = cnt > 0u ? cnt : 1u;
}
__device__ __forceinline__ void xcd_barrier(const XcdBarrier& b) {
    asm volatile("s_waitcnt vmcnt(0)" ::: "memory");
    __syncthreads();
    if (threadIdx.x == 0) {
        unsigned* bar = b.bar;
        __builtin_amdgcn_s_waitcnt(0);
        unsigned nloc = b.st[0], nx = b.st[1];
        if (nloc == 0u) { xcd_barrier_complete(bar, b.x, nloc, nx); b.st[0] = nloc; b.st[1] = nx; }
        const unsigned old = xb_add(&bar[XB_XSUB(b.x)], 1u);
        const unsigned gen = old / nloc;
        if (old + 1u == (gen + 1u) * nloc) {
            __builtin_amdgcn_fence(__ATOMIC_RELEASE, "agent");
            asm volatile("s_waitcnt vmcnt(0)" ::: "memory");
            const unsigned og = xb_add(&bar[XB_TOP], 1u);
            const unsigned tg = og / nx;
            if (og + 1u == (tg + 1u) * nx) xb_add(&bar[XB_TOPGEN], 1u);
            else XB_SPIN(xb_ld(&bar[XB_TOPGEN]) == tg, bar);
            __builtin_amdgcn_fence(__ATOMIC_ACQUIRE, "agent");
            xb_add(&bar[XB_XGEN(b.x)], 1u);
            asm volatile("s_waitcnt vmcnt(0)" ::: "memory");
        } else {
            XB_SPIN(xb_ld(&bar[XB_XGEN(b.x)]) == gen, bar);
            __builtin_amdgcn_fence(__ATOMIC_ACQUIRE, "agent");
            asm volatile("s_waitcnt vmcnt(0)" ::: "memory");
        }
    }
    __syncthreads();
}

constexpr int ATT_LDS = 3 * att::SHM_V + 3 * att::SHM_K + 8 * 64 * 4;
constexpr int LDS_MAIN = (2 * hg::GROUP_BYTES > pg8::STAGE_BYTES ? 2 * hg::GROUP_BYTES : pg8::STAGE_BYTES);
constexpr int LDS_BYTES = LDS_MAIN + 16;
constexpr size_t WS_BAR = WS_END + 1024, WS_END2 = WS_BAR + XCD_BAR_WORDS * 4;
static_assert(ATT_LDS <= LDS_MAIN, "lds");
#ifndef PH_MASK
#define PH_MASK 31
#endif
#ifndef ATT_UA
#define ATT_UA 12
#endif
constexpr int UA = ATT_UA, UB = 16 - ATT_UA;

__global__ void __launch_bounds__(NTHREADS, 2) fwd_megakernel(Params p) {
    extern __shared__ __attribute__((aligned(16))) unsigned char lds[];
    cg::grid_group grid = cg::this_grid();
    typedef const __attribute__((address_space(4))) Params* KPtr;
    const int G = gridDim.x, c = blockIdx.x;
    volatile LAS unsigned* st = (volatile LAS unsigned*)((LAS unsigned char*)lds + LDS_MAIN);
    if (threadIdx.x < 2) st[threadIdx.x] = 0u;
    { const long gt0 = (long)blockIdx.x * NTHREADS + threadIdx.x; if (gt0 < XCD_BAR_WORDS) __hip_atomic_store((unsigned*)(((KPtr)__builtin_amdgcn_kernarg_segment_ptr())->ws + WS_BAR) + gt0, 0u, __ATOMIC_RELAXED, __HIP_MEMORY_SCOPE_AGENT); }
    __syncthreads();
#define GSYNC() do { XcdBarrier b_; b_.bar = (unsigned*)(KP()->ws + WS_BAR); b_.x = xb_xcc_id(); b_.st = st; xcd_barrier(b_); } while (0)
#define IDS() int tid_ = threadIdx.x; asm volatile("" : "+v"(tid_)); const int lane = tid_ & 63; const long gtid = (long)blockIdx.x * NTHREADS + tid_, gthreads = (long)gridDim.x * NTHREADS; const int gwave = (int)(gtid >> 6), nwaves = (int)(gthreads >> 6); (void)lane; (void)gwave; (void)nwaves;
#define KP() ({ const unsigned long long _a = (unsigned long long)__builtin_amdgcn_kernarg_segment_ptr(); unsigned _lo = __builtin_amdgcn_readfirstlane((unsigned)_a), _hi = __builtin_amdgcn_readfirstlane((unsigned)(_a >> 32)); asm volatile("" : "+s"(_lo), "+s"(_hi)); (KPtr)(((unsigned long long)_hi << 32) | _lo); })
#define WSP(kp, off) ((kp)->ws + (off))
#ifdef PROBE_DUR
#define STAMP(k) do { if ((blockIdx.x == 0 || blockIdx.x == 128) && threadIdx.x == 0) { const unsigned long long now_ = __builtin_amdgcn_s_memrealtime(); \
        unsigned long long* T_ = (unsigned long long*)(KP()->ws + WS_END) + (blockIdx.x ? 16 : 0); T_[k] += now_ - T_[15]; T_[15] = now_; } } while (0)
    if ((blockIdx.x == 0 || blockIdx.x == 128) && threadIdx.x == 0) { unsigned long long* T_ = (unsigned long long*)(KP()->ws + WS_END) + (blockIdx.x ? 16 : 0);
        for (int i_ = 0; i_ < 15; ++i_) T_[i_] = 0; T_[15] = __builtin_amdgcn_s_memrealtime(); }
#else
#define STAMP(k) do { } while (0)
#endif
    { IDS();
    for (int l = 0; l < DEPTH; ++l) {
        KPtr kp = KP();
        transpose_w(kp->w_in + (size_t)l * DM * NIN, DM, NIN, (bf16_t*)WSP(kp, WS_WIN) + (size_t)l * NIN * DM, kp->norm_w + l * DM, true, (float*)lds);
        transpose_w(kp->w_ba + (size_t)l * DM * DM, DM, DM, (bf16_t*)WSP(kp, WS_WA) + (size_t)l * DM * DM, nullptr, false, (float*)lds);
        transpose_w(kp->w_bh + (size_t)l * DM * DM, DM, DM, (bf16_t*)WSP(kp, WS_WH) + (size_t)l * DM * DM, nullptr, false, (float*)lds);
        transpose_w(kp->w_out + (size_t)l * DM * DM, DM, DM, (bf16_t*)WSP(kp, WS_WO) + (size_t)l * DM * DM, nullptr, false, (float*)lds);
    }
    { KPtr kp = KP(); float* TAB = (float*)WSP(kp, WS_TAB);
    if (gtid < 1536) {
        const int pos = (int)(gtid >> 4), i = (int)(gtid & 15);
        const float inv = powf(10000.0f, -(float)i / 16.0f);
        if (pos < 32) { const float a = (float)pos * inv; TAB[TAB_COSR + pos * 16 + i] = cosf(a); TAB[TAB_SINR + pos * 16 + i] = sinf(a); }
        else { const int pc = pos - 32; const float a = (float)pc * inv; TAB[TAB_COSC + pc * 16 + i] = cosf(a); TAB[TAB_SINC + pc * 16 + i] = sinf(a); }
    }
    if (gtid >= 4096 && gtid < 4096 + DEPTH) {
        const int l = (int)(gtid - 4096); float mq = 0.f, mk = 0.f;
        for (int i = 0; i < 64; ++i) { mq = fmaxf(mq, fabsf(kp->q_norm_w[l * 64 + i])); mk = fmaxf(mk, fabsf(kp->k_norm_w[l * 64 + i])); }
        TAB[TAB_M2 + l] = 0.18033688011112042f * 64.0f * mq * mk;
    }
    if (gtid >= 2048 && gtid < 2048 + 2048) {
        const int d = (int)((gtid - 2048) >> 10), k = (int)((gtid - 2048) & 1023);
        const float a0 = kp->lbnd[(size_t)(d * DEPTH + 0) * 1024 + k], a1 = kp->lbnd[(size_t)(d * DEPTH + 1) * 1024 + k];
        const float m = fmaxf(a0, a1), e0 = expf(a0 - m), e1 = expf(a1 - m);
        TAB[TAB_LB + (d * 2 + 0) * 1024 + k] = 0.0f; TAB[TAB_LB + (d * 2 + 1) * 1024 + k] = e1 / (e0 + e1);
    }
    rowprep(kp->x, (bf16_t*)WSP(kp, WS_XB), (float*)WSP(kp, WS_RROW), gwave, nwaves, lane); } }
    grid.sync(); xcd_barrier_post((unsigned*)(KP()->ws + WS_BAR)); STAMP(0);

    for (int layer = 0; layer < DEPTH; ++layer) {
        for (int half = 0; half < 2; ++half) {
            const size_t tok0 = (size_t)half * TH;
#if PH_MASK & 1
            {
                KPtr kp = KP();
                pg8::Gemm g{(const bf16_t*)WSP(kp, WS_XB) + tok0 * DM, (const bf16_t*)WSP(kp, WS_WIN) + (size_t)layer * NIN * DM, nullptr, nullptr, TH, NIN, DM};
                pg8::StaticOrder S; S.init(TH, NIN, G, c);
                EpiProj E{(bf16_t*)WSP(kp, WS_PROJ), (const float*)WSP(kp, WS_RROW) + tok0, (const float*)WSP(kp, WS_TAB), kp->q_norm_w + layer * 64, kp->k_norm_w + layer * 64, half ? 8 : 6};
                pg8::gemm_phase<EpiProj, pg8::StaticOrder>((LAS unsigned char*)lds, g, S, E);
            }
#endif
            GSYNC(); STAMP(1);
            {
                KPtr kp = KP();
                bf16_t* PROJ = (bf16_t*)WSP(kp, WS_PROJ); const float* TAB = (const float*)WSP(kp, WS_TAB);
                const int xcd = c & 7, j = c >> 3;
                const bool light = c < 128;
#if PH_MASK & 2
                if (light) hg::hgrn_item((char*)lds, PROJ, c >> 3, c & 7, TAB + TAB_LB + (0 * 2 + layer) * 1024, TAB + TAB_LB + (1 * 2 + layer) * 1024, kp->hnorm_w + layer * 128);
#endif
                __syncthreads(); STAMP(2);
                const int nun = light ? UB : UA, ubase = light ? 16 * UA + j : (j - 16);
#if PH_MASK & 4
                for (int i = 0; i < nun; ++i) {
                    const int u = ubase + 16 * i, grp = xcd * 8 + (u >> 5), w = u & 31;
                    const int bl = grp >> 2, kvh = grp & 3, head = kvh * 4 + (w & 3), qb = w >> 2;
                    const size_t r0 = (size_t)bl * SEQ;
                    att::attn_unit(PROJ + PO_Q + (r0 + qb * 256) * 1024 + head * 64, PROJ + PO_K + r0 * 256 + kvh * 64, PROJ + PO_V + r0 * 256 + kvh * 64,
                                   PROJ + PO_AG + (r0 + qb * 256) * 1024 + head * 64, TAB[TAB_M2 + layer], (char*)lds);
                }
#endif
                STAMP(3);
            }
            GSYNC(); STAMP(4);
#if PH_MASK & 8
            {
                KPtr kp = KP(); bf16_t* PROJ = (bf16_t*)WSP(kp, WS_PROJ);
                pg8::Gemm g{PROJ + PO_Q, (const bf16_t*)WSP(kp, WS_WA) + (size_t)layer * DM * DM, PROJ + PO_HQ, (const bf16_t*)WSP(kp, WS_WH) + (size_t)layer * DM * DM, TH, DM, DM};
                pg8::TwoPassOrder S; S.S.init(TH, DM, G, c);
                EpiMerge E{PROJ + (half ? PO_MA1 : PO_MA), PROJ + PO_MH};
                pg8::gemm_phase<EpiMerge, pg8::TwoPassOrder>((LAS unsigned char*)lds, g, S, E);
            }
#endif
            GSYNC(); STAMP(5);
#if PH_MASK & 16
            {
                KPtr kp = KP(); bf16_t* PROJ = (bf16_t*)WSP(kp, WS_PROJ);
                pg8::Gemm g{PROJ + (half ? PO_MA1 : PO_MA), (const bf16_t*)WSP(kp, WS_WO) + (size_t)layer * DM * DM, nullptr, nullptr, TH, DM, DM};
                pg8::StaticOrder S; S.init(TH, DM, G, c);
                EpiResid E{(layer == 0 ? kp->x : (const float*)kp->out) + tok0 * DM, kp->out + tok0 * DM};
                pg8::gemm_phase<EpiResid, pg8::StaticOrder>((LAS unsigned char*)lds, g, S, E);
            }
#endif
            if (half == 1) GSYNC();
            STAMP(6);
        }
        if (layer + 1 < DEPTH) { IDS(); KPtr kp = KP(); rowprep(kp->out, (bf16_t*)WSP(kp, WS_XB), (float*)WSP(kp, WS_RROW), gwave, nwaves, lane); GSYNC(); STAMP(7); }
    }
    { IDS(); KPtr kp = KP(); final_norm(kp->out, kp->fnorm_w, gwave, nwaves, lane); }
#ifdef PROBE_DUR
    GSYNC(); STAMP(8);
    if (blockIdx.x == 0) {
        const unsigned long long* T_ = (const unsigned long long*)(KP()->ws + WS_END);
        const unsigned long long dt = T_[PROBE_DUR], nn = T_[PROBE_RVR] / 100;
        float* o_ = KP()->out;
        for (unsigned long long i_ = threadIdx.x; i_ < nn; i_ += NTHREADS) o_[i_ * 64] += 0.1f;
        const unsigned long long t0_ = __builtin_amdgcn_s_memrealtime();
        while (__builtin_amdgcn_s_memrealtime() - t0_ < dt) __builtin_amdgcn_s_sleep(8);
    }
#endif
}

extern "C" void kernel_launch(void* const* d_in, const int* in_sizes, int n_in, void* d_out, int out_size, void* d_ws, size_t ws_size, hipStream_t stream) {
    static int grid_blocks = 0;
    if (grid_blocks == 0) {
        if (n_in != 11 || in_sizes[0] != NTOK * DM || out_size != NTOK * DM || ws_size < WS_END2) {
            fprintf(stderr, "kernel_launch: shape mismatch (n_in %d, in0 %d, out %d, ws %zu, need %zu)\n", n_in, n_in > 0 ? in_sizes[0] : -1, out_size, ws_size, (size_t)WS_END); grid_blocks = -1; return; }
        int dev = 0, cus = 0, per_cu = 0;
        hipGetDevice(&dev); hipDeviceGetAttribute(&cus, hipDeviceAttributeMultiprocessorCount, dev);
        if (hipFuncSetAttribute((const void*)fwd_megakernel, hipFuncAttributeMaxDynamicSharedMemorySize, LDS_BYTES) != hipSuccess) { fprintf(stderr, "kernel_launch: hipFuncSetAttribute failed\n"); grid_blocks = -1; return; }
        hipOccupancyMaxActiveBlocksPerMultiprocessor(&per_cu, (const void*)fwd_megakernel, NTHREADS, LDS_BYTES);
        if (per_cu < 1) { fprintf(stderr, "kernel_launch: occupancy query says %d\n", per_cu); per_cu = 1; }
        (void)hipGetLastError();
        grid_blocks = cus;
    }
    if (grid_blocks < 0) return;
    Params p{};
    p.x = (const float*)d_in[0]; p.w_in = (const float*)d_in[1]; p.norm_w = (const float*)d_in[2]; p.q_norm_w = (const float*)d_in[3]; p.k_norm_w = (const float*)d_in[4];
    p.lbnd = (const float*)d_in[5]; p.hnorm_w = (const float*)d_in[6]; p.w_ba = (const float*)d_in[7]; p.w_bh = (const float*)d_in[8]; p.w_out = (const float*)d_in[9];
    p.fnorm_w = (const float*)d_in[10]; p.out = (float*)d_out; p.ws = (unsigned char*)d_ws;
    void* args[] = {&p};
    hipError_t e = hipLaunchCooperativeKernel((const void*)fwd_megakernel, dim3(grid_blocks), dim3(NTHREADS), args, LDS_BYTES, stream);
    if (e != hipSuccess) fprintf(stderr, "cooperative launch failed: %s (grid %d)\n", hipGetErrorString(e), grid_blocks);
}
```

```cpp
#include <hip/hip_runtime.h>
#include <hip/hip_cooperative_groups.h>
#include <cstdio>
#include <cstdint>
namespace cg = cooperative_groups;

#define LAS __attribute__((address_space(3)))
typedef unsigned short bf16_t;
typedef short bf16x8 __attribute__((ext_vector_type(8)));
typedef short s16x4 __attribute__((ext_vector_type(4)));
typedef float f32x4 __attribute__((ext_vector_type(4)));
typedef float f32x16 __attribute__((ext_vector_type(16)));
typedef unsigned u32x4 __attribute__((ext_vector_type(4)));
typedef unsigned u32x2 __attribute__((ext_vector_type(2)));

constexpr int DM = 1024, SEQ = 2048, BATCH = 32, NTOK = BATCH * SEQ, NIN = 9728, DEPTH = 2;
constexpr int HB = 16, TH = HB * SEQ;
constexpr float EPS = 1e-6f;
constexpr int NTHREADS = 512;

constexpr size_t SZ_WIN = (size_t)NIN * DM * 2, SZ_W1 = (size_t)DM * DM * 2;
constexpr size_t WS_WIN = 0, WS_WA = WS_WIN + 2 * SZ_WIN, WS_WH = WS_WA + 2 * SZ_W1, WS_WO = WS_WH + 2 * SZ_W1;
constexpr size_t WS_XB = WS_WO + 2 * SZ_W1, WS_RROW = WS_XB + (size_t)NTOK * DM * 2, WS_TAB = WS_RROW + (size_t)NTOK * 4;
constexpr int TAB_COSR = 0, TAB_SINR = 512, TAB_COSC = 1024, TAB_SINC = 2048, TAB_LB = 3072, TAB_M2 = 3072 + 2 * 2 * 1024, TAB_FLOATS = TAB_M2 + 64;
constexpr size_t WS_PROJ = (WS_TAB + TAB_FLOATS * 4 + 255) / 256 * 256;
constexpr size_t PO_Q = 0, PO_K = (size_t)TH * 1024, PO_V = (size_t)TH * 1280, PO_AG = (size_t)TH * 1536, PO_HQ = PO_AG + (size_t)TH * 1024,
                 PO_ZF = PO_HQ + (size_t)TH * 1024, PO_ZB = PO_ZF + (size_t)TH * 1024, PO_HI = PO_ZB + (size_t)TH * 1024, PO_HG = PO_HI + (size_t)TH * 1024,
                 PO_MA = PO_HG + (size_t)TH * 1024, PO_MH = PO_MA + (size_t)TH * 1024, PO_MA1 = PO_MH + (size_t)TH * 1024, PO_END = PO_MA1 + (size_t)TH * 1024;
constexpr size_t WS_END = WS_PROJ + PO_END * 2;

struct Params {
    const float* x; const float* w_in; const float* norm_w; const float* q_norm_w; const float* k_norm_w; const float* lbnd; const float* hnorm_w;
    const float* w_ba; const float* w_bh; const float* w_out; const float* fnorm_w; float* out; unsigned char* ws;
};

typedef float f32x2_t __attribute__((ext_vector_type(2))); typedef __bf16 bf16x2_t __attribute__((ext_vector_type(2)));
__device__ __forceinline__ unsigned cvt_pk_bf16(float lo, float hi) { f32x2_t v = {lo, hi}; bf16x2_t b = __builtin_convertvector(v, bf16x2_t); return __builtin_bit_cast(unsigned, b); }
__device__ __forceinline__ unsigned cvt_pk_bf16_asm(float lo, float hi) { unsigned r; asm volatile("v_cvt_pk_bf16_f32 %0, %1, %2" : "=v"(r) : "v"(lo), "v"(hi)); return r; }
__device__ __forceinline__ float bf2f(unsigned short v) { return __uint_as_float((unsigned)v << 16); }
__device__ __forceinline__ float bflo(unsigned w) { return __uint_as_float(w << 16); }
__device__ __forceinline__ float bfhi(unsigned w) { return __uint_as_float(w & 0xffff0000u); }
__device__ __forceinline__ unsigned pack_h2(float a, float b) { _Float16 ha = (_Float16)a, hb = (_Float16)b; return (unsigned)__builtin_bit_cast(unsigned short, ha) | ((unsigned)__builtin_bit_cast(unsigned short, hb) << 16); }
__device__ __forceinline__ float h2f(unsigned short v) { return (float)__builtin_bit_cast(_Float16, v); }
__device__ __forceinline__ float sigmoidf_(float x) { return __builtin_amdgcn_rcpf(1.0f + __expf(-x)); }
__device__ __forceinline__ float siluf_(float x) { return x * __builtin_amdgcn_rcpf(1.0f + __expf(-x)); }
#define LDS_BAR() do { asm volatile("s_waitcnt lgkmcnt(0)" ::: "memory"); __builtin_amdgcn_s_barrier(); asm volatile("" ::: "memory"); } while (0)

#ifdef PROBE_DUR
#define GSTAMP(k) do { if (blockIdx.x == 0 && threadIdx.x == 0) { asm volatile("s_waitcnt vmcnt(0)" ::: "memory"); const unsigned long long now_ = __builtin_amdgcn_s_memrealtime(); \
        unsigned long long* T_ = (unsigned long long*)(((const __attribute__((address_space(4))) Params*)__builtin_amdgcn_kernarg_segment_ptr())->ws + WS_END); T_[k] += now_ - T_[15]; T_[15] = now_; } } while (0)
#else
#define GSTAMP(k) do { } while (0)
#endif
namespace pg8 {
constexpr int BM = 256, BK = 64, HALF = 128, HTB = HALF * BK * 2, STAGE_BYTES = 8 * HTB, NXCD = 8, WGM = 8;
__host__ __device__ __forceinline__ int lds_byte(int r, int c) { const int st = (r >> 4) * 2 + (c >> 5), rr = r & 15, cc = c & 31, ob = rr * 64 + cc * 2; return st * 1024 + (ob ^ (((ob >> 9) & 1) << 5)); }
__host__ __device__ __forceinline__ void stage_rc(int b, int& R, int& C) { const int st = b / 1024, sb = b % 1024, swz = sb ^ (((sb >> 9) & 1) << 5); R = (st >> 1) * 16 + swz / 64; C = (st & 1) * 32 + (swz % 64) / 2; }
__host__ __device__ __forceinline__ int perm32(int rho) { const int n = rho >> 4, i = rho & 15; return 8 * (i >> 2) + 4 * n + (i & 3); }

struct Unit { int pm, pn, z; };
struct Gemm { const bf16_t* A0; const bf16_t* B0; const bf16_t* A1; const bf16_t* B1; int M, N, K; };

struct StaticOrder {
    int nM, nN, nwg, G, c;
    __device__ void init(int M, int N, int G_, int c_) { nM = M / BM; nN = N / BM; nwg = nM * nN; G = G_; c = c_; }
    __device__ bool next(int i, Unit& u) const {
        const long L = (long)i * G + c; if (L >= nwg) return false;
        int wgid = (int)L; { const int q = nwg / NXCD, r = nwg % NXCD, xcd = wgid % NXCD, off = wgid / NXCD; wgid = (xcd < r ? xcd * (q + 1) : r * (q + 1) + (xcd - r) * q) + off; }
        const int nig = WGM * nN, gid = wgid / nig, fm = gid * WGM, gsz = (nM - fm) < WGM ? (nM - fm) : WGM;
        u.pm = fm + ((wgid % nig) % gsz); u.pn = (wgid % nig) / gsz; u.z = 0; return true;
    }
};
struct TwoPassOrder {
    StaticOrder S;
    __device__ bool next(int i, Unit& u) const { if (!S.next(i >> 1, u)) return false; u.z = i & 1; return true; }
};

template <class Epi, class Sched>
__device__ __forceinline__ void gemm_phase(LAS unsigned char* lds, const Gemm g, const Sched& S, const Epi& E) {
    int tid = threadIdx.x; asm volatile("" : "+v"(tid));
    const int wid = __builtin_amdgcn_readfirstlane(tid >> 6), lane = tid & 63, wr = wid >> 2, wc = wid & 3, fr = lane & 15, fq = lane >> 4;
    const int K = g.K, nt = K / BK;
    unsigned voffA[2], voffB[2];
#pragma unroll
    for (int i = 0; i < 2; ++i) { int R, C; stage_rc(tid * 16 + i * 8192, R, C); const int Rb = Epi::PERM ? ((R & ~31) + perm32(R & 31)) : R;
        voffA[i] = (unsigned)(R * K + C) * 2u; voffB[i] = (unsigned)(Rb * K + C) * 2u; }
    const size_t kstep = (size_t)(BK * 2);
    const size_t hstep = (size_t)HALF * K * 2;
    const size_t tstep = 2 * hstep;
    const unsigned ldsw = (unsigned)wid * 1024u;
    const int aoff = lds_byte(wr * 64 + fr, fq * 8), boff = lds_byte(wc * 32 + fr, fq * 8);
#define PG8_SA(b, h) (((b) * 2 + (h)) * HTB)
#define PG8_SB(b, h) ((4 + (b) * 2 + (h)) * HTB)
#define PG8_STAGE(bufoff, gbase, voff) do { _Pragma("unroll") for (int _i = 0; _i < 2; ++_i) \
        __builtin_amdgcn_global_load_lds((const unsigned*)((const char*)(gbase) + (voff)[_i]), (LAS unsigned*)(lds + (bufoff) + ldsw + _i * 8192), 16, 0, 0); } while (0)
#define PG8_LDA(dst, b, h) do { _Pragma("unroll") for (int m = 0; m < 4; ++m) _Pragma("unroll") for (int k = 0; k < 2; ++k) dst[m][k] = *(const LAS bf16x8*)(lds + PG8_SA(b, h) + aoff + m * 2048 + k * 1024); } while (0)
#define PG8_LDB(dst, b, h) do { _Pragma("unroll") for (int n = 0; n < 2; ++n) _Pragma("unroll") for (int k = 0; k < 2; ++k) dst[n][k] = *(const LAS bf16x8*)(lds + PG8_SB(b, h) + boff + n * 2048 + k * 1024); } while (0)
#define PG8_MMA(ai, bj, At, Bt) do { __builtin_amdgcn_s_setprio(1); _Pragma("unroll") for (int m = 0; m < 4; ++m) _Pragma("unroll") for (int n = 0; n < 2; ++n) _Pragma("unroll") for (int k = 0; k < 2; ++k) \
        acc[ai][bj][m][n] = __builtin_amdgcn_mfma_f32_16x16x32_bf16(Bt[n][k], At[m][k], acc[ai][bj][m][n], 0, 0, 0); __builtin_amdgcn_s_setprio(0); } while (0)
#define PG8_WAIT_V(n) asm volatile("s_waitcnt vmcnt(" #n ")" ::: "memory")
#define PG8_WAIT_L(n) asm volatile("s_waitcnt lgkmcnt(" #n ")" ::: "memory")
#define PG8_BAR __builtin_amdgcn_s_barrier()
#define PG8_SCHED __builtin_amdgcn_sched_barrier(0)
    Unit cur, nxt; int ui = 0;
    if (!S.next(0, cur)) return;
    f32x4 acc[2][2][4][2];
#pragma unroll
    for (int a = 0; a < 2; ++a)
#pragma unroll
        for (int b = 0; b < 2; ++b)
#pragma unroll
            for (int m = 0; m < 4; ++m)
#pragma unroll
                for (int n = 0; n < 2; ++n) acc[a][b][m][n] = (f32x4){0.f, 0.f, 0.f, 0.f};
    bf16x8 At[4][2], B0[2][2], B1[2][2];
    const char* cA = (const char*)(cur.z ? g.A1 : g.A0) + (size_t)cur.pm * tstep; const char* cB = (const char*)(cur.z ? g.B1 : g.B0) + (size_t)cur.pn * tstep;
    PG8_STAGE(PG8_SB(0, 0), cB, voffB); PG8_STAGE(PG8_SB(0, 1), cB + hstep, voffB); PG8_STAGE(PG8_SA(0, 0), cA, voffA); PG8_STAGE(PG8_SA(0, 1), cA + hstep, voffA);
    if (wr == 1) PG8_BAR;
    PG8_WAIT_V(2); PG8_BAR;
    PG8_STAGE(PG8_SB(1, 0), cB + kstep, voffB); PG8_STAGE(PG8_SA(1, 0), cA + kstep, voffA); PG8_STAGE(PG8_SB(1, 1), cB + hstep + kstep, voffB);
    PG8_WAIT_V(6); PG8_BAR;
    for (;;) {
        const bool has_next = S.next(ui + 1, nxt);
        const char* nA = has_next ? (const char*)(nxt.z ? g.A1 : g.A0) + (size_t)nxt.pm * tstep : cA; const char* nB = has_next ? (const char*)(nxt.z ? g.B1 : g.B0) + (size_t)nxt.pn * tstep : cB;
        for (int t = 0; t < nt; t += 2) {
            const bool last = (t == nt - 2);
            const char* a1 = cA + (size_t)(t + 1) * kstep;
            const char* a2 = last ? nA : cA + (size_t)(t + 2) * kstep; const char* b2 = last ? nB : cB + (size_t)(t + 2) * kstep;
            const char* a3 = a2 + kstep; const char* b3 = b2 + kstep;
            PG8_LDB(B0, 0, 0); PG8_LDB(B1, 0, 1); PG8_SCHED; PG8_LDA(At, 0, 0); PG8_STAGE(PG8_SA(1, 1), a1 + hstep, voffA);
            PG8_WAIT_V(8); PG8_WAIT_L(0); PG8_BAR; PG8_MMA(0, 0, At, B0); PG8_MMA(0, 1, At, B1); PG8_BAR; PG8_SCHED;
            PG8_LDA(At, 0, 1); PG8_STAGE(PG8_SB(0, 0), b2, voffB); PG8_STAGE(PG8_SB(0, 1), b2 + hstep, voffB); PG8_STAGE(PG8_SA(0, 0), a2, voffA);
            PG8_WAIT_V(8); PG8_WAIT_L(0); PG8_BAR; PG8_MMA(1, 0, At, B0); PG8_MMA(1, 1, At, B1); PG8_BAR; PG8_SCHED;
            PG8_LDB(B0, 1, 0); PG8_LDB(B1, 1, 1); PG8_SCHED; PG8_LDA(At, 1, 0); PG8_STAGE(PG8_SA(0, 1), a2 + hstep, voffA);
            PG8_WAIT_V(8); PG8_WAIT_L(0); PG8_BAR; PG8_MMA(0, 0, At, B0); PG8_MMA(0, 1, At, B1); PG8_BAR; PG8_SCHED;
            PG8_LDA(At, 1, 1); PG8_STAGE(PG8_SB(1, 0), b3, voffB); PG8_STAGE(PG8_SB(1, 1), b3 + hstep, voffB); PG8_STAGE(PG8_SA(1, 0), a3, voffA);
            PG8_WAIT_V(8); PG8_WAIT_L(0); PG8_BAR; PG8_MMA(1, 0, At, B0); PG8_MMA(1, 1, At, B1); PG8_BAR; PG8_SCHED;
        }
        if (wr == 0) PG8_BAR;
        GSTAMP(10);
        E(acc, cur, wr, wc, fr, fq);
        GSTAMP(11);
        if (!has_next) break;
        if (!(Epi::CARRY && cur.z == 0)) {
#pragma unroll
        for (int a = 0; a < 2; ++a)
#pragma unroll
            for (int b = 0; b < 2; ++b)
#pragma unroll
                for (int m = 0; m < 4; ++m)
#pragma unroll
                    for (int n = 0; n < 2; ++n) acc[a][b][m][n] = (f32x4){0.f, 0.f, 0.f, 0.f};
        }
        cur = nxt; cA = nA; cB = nB; ++ui;
        if (wr == 1) PG8_BAR;
    }
    PG8_WAIT_V(0);
    PG8_BAR;
#undef PG8_SA
#undef PG8_SB
#undef PG8_STAGE
#undef PG8_LDA
#undef PG8_LDB
#undef PG8_MMA
#undef PG8_WAIT_V
#undef PG8_WAIT_L
#undef PG8_BAR
#undef PG8_SCHED
}
}

struct EpiProj {
    static constexpr bool PERM = true, CARRY = false;
    bf16_t* proj; const float* rrow; const float* tab; const float* qw; const float* kw; int ma_sg;
    __device__ __forceinline__ void operator()(f32x4 (&acc)[2][2][4][2], const pg8::Unit& u, int wr, int wc, int fr, int fq) const {
        const int pn = u.pn;
        if (pn < 5) {
            const float* nw = (pn < 4) ? qw : kw;
            bf16_t* base = (pn < 4) ? (proj + PO_Q + pn * 256) : (proj + PO_K);
            const int ldc = (pn < 4) ? 1024 : 256;
#pragma unroll
            for (int ai = 0; ai < 2; ++ai)
#pragma unroll
                for (int m = 0; m < 4; ++m) {
                    const int row = u.pm * 256 + ai * 128 + wr * 64 + m * 16 + fr;
                    const int s = row & (SEQ - 1), prow = s >> 6, pcol = s & 63;
                    float ss = 0.f;
#pragma unroll
                    for (int bj = 0; bj < 2; ++bj)
#pragma unroll
                        for (int n = 0; n < 2; ++n) { const f32x4 q = acc[ai][bj][m][n] * acc[ai][bj][m][n]; ss += (q[0] + q[1]) + (q[2] + q[3]); }
                    ss += __shfl_xor(ss, 16); ss += __shfl_xor(ss, 32);
                    const float sc = ((pn < 4) ? 0.18033688011112042f : 1.0f) / sqrtf(ss * (1.0f / 64.0f) + EPS);
#pragma unroll
                    for (int bj = 0; bj < 2; ++bj) {
                        const f32x4 c = *(const f32x4*)(tab + (bj ? TAB_COSC + pcol * 16 : TAB_COSR + prow * 16) + 4 * fq);
                        const f32x4 sn = *(const f32x4*)(tab + (bj ? TAB_SINC + pcol * 16 : TAB_SINR + prow * 16) + 4 * fq);
                        const f32x4 w0 = *(const f32x4*)(nw + 32 * bj + 4 * fq), w1 = *(const f32x4*)(nw + 32 * bj + 16 + 4 * fq);
                        const f32x4 x1 = acc[ai][bj][m][0] * sc * w0, x2 = acc[ai][bj][m][1] * sc * w1;
                        const f32x4 o1 = x1 * c - x2 * sn, o2 = x2 * c + x1 * sn;
                        u32x4 w; w.x = cvt_pk_bf16(o1[0], o1[1]); w.y = cvt_pk_bf16(o1[2], o1[3]); w.z = cvt_pk_bf16(o2[0], o2[1]); w.w = cvt_pk_bf16(o2[2], o2[3]);
                        *(u32x4*)(base + (size_t)row * ldc + wc * 64 + bj * 32 + 8 * fq) = w;
                    }
                    if (m & 1) asm volatile("" ::: "memory");
                }
        } else {
            bf16_t* base; int ldc = 1024; bool f16 = false;
            if (pn == 5) { base = proj + PO_V; ldc = 256; }
            else { const int sg = (pn - 6) >> 2; base = proj + PO_AG + (size_t)(sg == 6 ? ma_sg : sg) * ((size_t)TH * 1024) + ((pn - 6) & 3) * 256; f16 = (sg == 2 || sg == 3); }
            const int col0 = wc * 32 + 8 * fq; const bool hq = (pn >= 10 && pn < 14), hgs = (pn >= 26 && pn < 30);
#pragma unroll
            for (int ai = 0; ai < 2; ++ai)
#pragma unroll
                for (int m = 0; m < 4; ++m) {
                    const int row = u.pm * 256 + ai * 128 + wr * 64 + m * 16 + fr;
                    bf16_t* rowp = base + (size_t)row * ldc + col0;
#pragma unroll
                    for (int bj = 0; bj < 2; ++bj) {
                        f32x4 v0 = acc[ai][bj][m][0], v1 = acc[ai][bj][m][1]; u32x4 w;
                        if (hq) {
#pragma unroll
                            for (int e = 0; e < 4; ++e) { v0[e] = siluf_(v0[e]) * 0.08838834764831845f; v1[e] = siluf_(v1[e]) * 0.08838834764831845f; } }
                        if (hgs) {
#pragma unroll
                            for (int e = 0; e < 4; ++e) { v0[e] = siluf_(v0[e]); v1[e] = siluf_(v1[e]); } }
                        if (f16) {
#pragma unroll
                            for (int e = 0; e < 4; ++e) { v0[e] = sigmoidf_(v0[e]); v1[e] = sigmoidf_(v1[e]); } }
                        if (f16) { w.x = pack_h2(v0[0], v0[1]); w.y = pack_h2(v0[2], v0[3]); w.z = pack_h2(v1[0], v1[1]); w.w = pack_h2(v1[2], v1[3]); }
                        else { w.x = cvt_pk_bf16(v0[0], v0[1]); w.y = cvt_pk_bf16(v0[2], v0[3]); w.z = cvt_pk_bf16(v1[0], v1[1]); w.w = cvt_pk_bf16(v1[2], v1[3]); }
                        *(u32x4*)(rowp + bj * 128) = w;
                    }
                }
        }
    }
};
struct EpiMerge {
    static constexpr bool PERM = true, CARRY = true;
    bf16_t* MA; const bf16_t* MH;
    __device__ __forceinline__ void operator()(f32x4 (&acc)[2][2][4][2], const pg8::Unit& u, int wr, int wc, int fr, int fq) const {
        const int col0 = u.pn * 256 + wc * 32 + 8 * fq;
#pragma unroll
        for (int ai = 0; ai < 2; ++ai)
#pragma unroll
            for (int m = 0; m < 4; ++m) {
                const int row = u.pm * 256 + ai * 128 + wr * 64 + m * 16 + fr;
#pragma unroll
                for (int bj = 0; bj < 2; ++bj) {
                    const size_t off = (size_t)row * 1024 + col0 + bj * 128;
                    const u32x4 g = *(const u32x4*)(MH + off);
                    const unsigned gw[4] = {g.x, g.y, g.z, g.w};
                    if (u.z == 0) {
                        const u32x4 a = *(const u32x4*)(MA + off);
                        const unsigned aw[4] = {a.x, a.y, a.z, a.w};
#pragma unroll
                        for (int q = 0; q < 4; ++q) {
                            const float r0 = (1.0f + __expf(-bflo(gw[q]))) * __builtin_amdgcn_rcpf(1.0f + __expf(-bflo(aw[q])));
                            const float r1 = (1.0f + __expf(-bfhi(gw[q]))) * __builtin_amdgcn_rcpf(1.0f + __expf(-bfhi(aw[q])));
                            acc[ai][bj][m][q >> 1][2 * (q & 1)] *= r0; acc[ai][bj][m][q >> 1][2 * (q & 1) + 1] *= r1;
                        }
                    } else {
                        float r[8];
#pragma unroll
                        for (int q = 0; q < 4; ++q) { r[2 * q] = sigmoidf_(bflo(gw[q])) * acc[ai][bj][m][q >> 1][2 * (q & 1)]; r[2 * q + 1] = sigmoidf_(bfhi(gw[q])) * acc[ai][bj][m][q >> 1][2 * (q & 1) + 1]; }
                        u32x4 w; w.x = cvt_pk_bf16(r[0], r[1]); w.y = cvt_pk_bf16(r[2], r[3]); w.z = cvt_pk_bf16(r[4], r[5]); w.w = cvt_pk_bf16(r[6], r[7]);
                        *(u32x4*)(MA + off) = w;
                    }
                }
                if (m == 3) asm volatile("" ::: "memory");
            }
    }
};
struct EpiResid {
    static constexpr bool PERM = false, CARRY = false;
    const float* xin; float* out;
    __device__ __forceinline__ void operator()(f32x4 (&acc)[2][2][4][2], const pg8::Unit& u, int wr, int wc, int fr, int fq) const {
        const int col0 = u.pn * 256 + wc * 32 + 4 * fq;
#pragma unroll
        for (int ai = 0; ai < 2; ++ai)
#pragma unroll
            for (int m = 0; m < 4; ++m) {
                const size_t off = (size_t)(u.pm * 256 + ai * 128 + wr * 64 + m * 16 + fr) * 1024 + col0;
#pragma unroll
                for (int bj = 0; bj < 2; ++bj)
#pragma unroll
                    for (int n = 0; n < 2; ++n) { const f32x4 b = *(const f32x4*)(xin + off + bj * 128 + n * 16); *(f32x4*)(out + off + bj * 128 + n * 16) = b + acc[ai][bj][m][n]; }
                if (m == 3) asm volatile("" ::: "memory");
            }
    }
};

namespace att {
constexpr int QBLK = 32, KVBLK = 64, LDQ = 1024, LDK = 256;
constexpr float SCALE = 0.125f, THR = 8.f;
constexpr int SHM_V = 8192, SHM_K = 8192;
__device__ __forceinline__ int crow(int r, int hi) { return (r & 3) + 8 * (r >> 2) + 4 * hi; }
#define SBAR() __builtin_amdgcn_sched_barrier(0)
__device__ __forceinline__ void partialSM(f32x16& p0) {
#pragma unroll
    for (int r = 0; r < 16; ++r) p0[r] = __builtin_amdgcn_exp2f(p0[r]);
}
__device__ __forceinline__ void finishSM(f32x16& p0, f32x16& p1, bf16x8& pa0, bf16x8& pa1, bf16x8& pa2, bf16x8& pa3) {
#pragma unroll
    for (int r = 0; r < 16; ++r) p1[r] = __builtin_amdgcn_exp2f(p1[r]);
#define PK4(P, BASE, OUT) do { unsigned a0 = cvt_pk_bf16(P[BASE + 0], P[BASE + 1]), a1 = cvt_pk_bf16(P[BASE + 2], P[BASE + 3]);   \
    unsigned b0 = cvt_pk_bf16(P[BASE + 4], P[BASE + 5]), b1 = cvt_pk_bf16(P[BASE + 6], P[BASE + 7]);                              \
    auto r0 = __builtin_amdgcn_permlane32_swap(a0, b0, false, false); auto r1 = __builtin_amdgcn_permlane32_swap(a1, b1, false, false); \
    u32x4 w = {r0[0], r1[0], r0[1], r1[1]}; OUT = *reinterpret_cast<bf16x8*>(&w); } while (0)
    PK4(p0, 0, pa0); PK4(p0, 8, pa1); PK4(p1, 0, pa2); PK4(p1, 8, pa3);
#undef PK4
}
__device__ __forceinline__ void qkt(f32x16& p0, f32x16& p1, const char* Ks, const bf16x8* qr, const f32x16& negm, int r32, int hi) {
    p0 = negm; p1 = negm;
#pragma unroll
    for (int d0 = 0; d0 < 4; ++d0) {
        const bf16x8 b0 = *reinterpret_cast<const bf16x8*>(Ks + (2 * d0 + hi) * 1024 + r32 * 16);
        const bf16x8 b1 = *reinterpret_cast<const bf16x8*>(Ks + (2 * d0 + hi) * 1024 + 512 + r32 * 16);
        p0 = __builtin_amdgcn_mfma_f32_32x32x16_bf16(b0, qr[d0], p0, 0, 0, 0);
        p1 = __builtin_amdgcn_mfma_f32_32x32x16_bf16(b1, qr[d0], p1, 0, 0, 0); }
}
__device__ __forceinline__ int v_st(int k, int c) { const int kk = (k & ~0xC) | ((k & 4) << 1) | ((k & 8) >> 1); return ((kk >> 3) * 2 + (c >> 5)) * 512 + ((kk & 7) * 32 + (c & 31)) * 2; }
__device__ __forceinline__ int v_rd_base(int lane) { return ((lane & 3) << 3) | (((lane >> 2) & 3) << 6) | (((lane >> 4) & 1) << 5) | (((lane >> 5) & 1) << 8); }
constexpr int v_rd_off(int d0, int ks, int half) { return d0 * 512 + ks * 2048 + half * 1024; }
template <int OFF> __device__ __forceinline__ s16x4 tr_read(int vb) { s16x4 r; asm volatile("ds_read_b64_tr_b16 %0, %1 offset:%2" : "=&v"(r) : "v"(vb), "i"(OFF) : "memory"); return r; }
template <int D0> __device__ __forceinline__ void pv_one(f32x16& od, int vb, bf16x8 pa0, bf16x8 pa1, bf16x8 pa2, bf16x8 pa3) {
    const s16x4 l0 = tr_read<v_rd_off(D0, 0, 0)>(vb), h0 = tr_read<v_rd_off(D0, 0, 1)>(vb), l1 = tr_read<v_rd_off(D0, 1, 0)>(vb), h1 = tr_read<v_rd_off(D0, 1, 1)>(vb);
    const s16x4 l2 = tr_read<v_rd_off(D0, 2, 0)>(vb), h2 = tr_read<v_rd_off(D0, 2, 1)>(vb), l3 = tr_read<v_rd_off(D0, 3, 0)>(vb), h3 = tr_read<v_rd_off(D0, 3, 1)>(vb);
    asm volatile("s_waitcnt lgkmcnt(0)" ::: "memory"); SBAR();
#define PK(L, H) (bf16x8){L[0], L[1], L[2], L[3], H[0], H[1], H[2], H[3]}
    od = __builtin_amdgcn_mfma_f32_32x32x16_bf16(pa0, PK(l0, h0), od, 0, 0, 0);
    od = __builtin_amdgcn_mfma_f32_32x32x16_bf16(pa1, PK(l1, h1), od, 0, 0, 0);
    od = __builtin_amdgcn_mfma_f32_32x32x16_bf16(pa2, PK(l2, h2), od, 0, 0, 0);
    od = __builtin_amdgcn_mfma_f32_32x32x16_bf16(pa3, PK(l3, h3), od, 0, 0, 0);
#undef PK
}
__device__ __forceinline__ void pv_d0(f32x16* o, f32x16& lacc, int vb, bf16x8 pa0, bf16x8 pa1, bf16x8 pa2, bf16x8 pa3) {
    const bf16x8 ones = (bf16x8){0x3F80, 0x3F80, 0x3F80, 0x3F80, 0x3F80, 0x3F80, 0x3F80, 0x3F80};
    pv_one<0>(o[0], vb, pa0, pa1, pa2, pa3);
    lacc = __builtin_amdgcn_mfma_f32_32x32x16_bf16(pa0, ones, lacc, 0, 0, 0);
    lacc = __builtin_amdgcn_mfma_f32_32x32x16_bf16(pa1, ones, lacc, 0, 0, 0);
    pv_one<1>(o[1], vb, pa0, pa1, pa2, pa3);
    lacc = __builtin_amdgcn_mfma_f32_32x32x16_bf16(pa2, ones, lacc, 0, 0, 0);
    lacc = __builtin_amdgcn_mfma_f32_32x32x16_bf16(pa3, ones, lacc, 0, 0, 0);
}

__device__ __forceinline__ void attn_unit(bf16_t* Qb, const bf16_t* __restrict__ Kh, const bf16_t* __restrict__ Vh, const bf16_t* __restrict__ Gb, float m2, char* lds) {
    int tid = threadIdx.x; asm volatile("" : "+v"(tid));
    const int wid = tid >> 6, lane = tid & 63, r32 = lane & 31, hi = lane >> 5;
    char* V_lds = lds; char* K_lds = lds + 3 * SHM_V;
    float* ws = (float*)(lds + 3 * SHM_V + 3 * SHM_K) + wid * 64; float* li_l = ws;
    f32x16 lacc = {}; f32x16 o[2] = {}; bf16x8 qr[4];
    f32x16 negm;
#pragma unroll
    for (int r = 0; r < 16; ++r) negm[r] = -m2;
    const bf16_t* Qw = Qb + (size_t)(wid * QBLK + r32) * LDQ + hi * 8;
#pragma unroll
    for (int d0 = 0; d0 < 4; ++d0) qr[d0] = *reinterpret_cast<const bf16x8*>(Qw + d0 * 16);
    const int krow = tid & 63, kch = tid >> 6, kst = kch * 1024 + krow * 16;
    const int sr = tid >> 3, sc = (tid & 7) * 8, vst0 = v_st(sr, sc);
    const int vb0 = (int)(uintptr_t)V_lds + v_rd_base(lane);
    bf16x8 svA, skA, svB, skB;
#define SLOADA(k0) do { svA = *reinterpret_cast<const bf16x8*>(&Vh[(size_t)((k0) + sr) * LDK + sc]); skA = *reinterpret_cast<const bf16x8*>(&Kh[(size_t)((k0) + krow) * LDK + kch * 8]); } while (0)
#define SLOADB(k0) do { svB = *reinterpret_cast<const bf16x8*>(&Vh[(size_t)((k0) + sr) * LDK + sc]); skB = *reinterpret_cast<const bf16x8*>(&Kh[(size_t)((k0) + krow) * LDK + kch * 8]); } while (0)
#define SWRITEA(bo) do { *(bf16x8*)(V_lds + (bo) + vst0) = svA; *(bf16x8*)(K_lds + (bo) + kst) = skA; } while (0)
#define SWRITEB(bo) do { *(bf16x8*)(V_lds + (bo) + vst0) = svB; *(bf16x8*)(K_lds + (bo) + kst) = skB; } while (0)
    f32x16 pA0, pA1, pB0, pB1; bf16x8 pa0, pa1, pa2, pa3; constexpr int NT = SEQ / KVBLK;
    static_assert(SHM_V == SHM_K, "one rotating offset serves both rings");
    SLOADA(0); SLOADB(KVBLK); asm volatile("s_waitcnt vmcnt(2)" ::: "memory"); SWRITEA(0); SLOADA(2 * KVBLK); __syncthreads();
    SWRITEB(SHM_V); SLOADB(3 * KVBLK);
    qkt(pA0, pA1, K_lds, qr, negm, r32, hi); partialSM(pA0);
    __syncthreads();
    int bp = 0, bc = SHM_V, bn = 2 * SHM_V;
#define ROT3() do { const int t_ = bp; bp = bc; bc = bn; bn = t_; } while (0)
#define STEP_ODD(j) do { \
        SBAR(); qkt(pB0, pB1, K_lds + bc, qr, negm, r32, hi); \
        finishSM(pA0, pA1, pa0, pa1, pa2, pa3); SBAR(); \
        if ((j) + 1 < NT) SWRITEA(bn); \
        if ((j) + 3 < NT) SLOADA(((j) + 3) * KVBLK); SBAR(); \
        pv_d0(o, lacc, vb0 + bp, pa0, pa1, pa2, pa3); partialSM(pB0); \
        __syncthreads(); ROT3(); } while (0)
#define STEP_EVEN(j) do { \
        SBAR(); qkt(pA0, pA1, K_lds + bc, qr, negm, r32, hi); \
        finishSM(pB0, pB1, pa0, pa1, pa2, pa3); SBAR(); \
        if ((j) + 1 < NT) SWRITEB(bn); \
        if ((j) + 3 < NT) SLOADB(((j) + 3) * KVBLK); SBAR(); \
        pv_d0(o, lacc, vb0 + bp, pa0, pa1, pa2, pa3); partialSM(pA0); \
        __syncthreads(); ROT3(); } while (0)
    for (int j = 1; j + 1 < NT; j += 2) { STEP_ODD(j); STEP_EVEN(j + 1); }
    STEP_ODD(NT - 1);
    finishSM(pB0, pB1, pa0, pa1, pa2, pa3); SBAR();
    pv_d0(o, lacc, vb0 + bp, pa0, pa1, pa2, pa3);
#undef STEP_ODD
#undef STEP_EVEN
#undef ROT3
    float rli[16];
#pragma unroll
    for (int r = 0; r < 16; ++r) rli[r] = __builtin_amdgcn_rcpf(lacc[r]);
    __syncthreads();
    bf16_t* stg = (bf16_t*)lds + wid * 2048;
#pragma unroll
    for (int r = 0; r < 16; ++r) { const int orow = crow(r, hi);
#pragma unroll
        for (int d0 = 0; d0 < 2; ++d0) stg[orow * 64 + d0 * 32 + r32] = (bf16_t)(cvt_pk_bf16(o[d0][r] * rli[r], 0.f) & 0xffffu); }
    asm volatile("s_waitcnt lgkmcnt(0)" ::: "memory");
#pragma unroll
    for (int i = 0; i < 4; ++i) {
        const int row = i * 8 + (lane >> 3), ch = lane & 7;
        const u32x4 v = *(const u32x4*)(stg + row * 64 + ch * 8);
        const size_t goff = (size_t)(wid * QBLK + row) * LDQ + ch * 8;
        const u32x4 g = *(const u32x4*)(Gb + goff);
        u32x4 w;
        w.x = cvt_pk_bf16(bflo(v.x) * siluf_(bflo(g.x)), bfhi(v.x) * siluf_(bfhi(g.x))); w.y = cvt_pk_bf16(bflo(v.y) * siluf_(bflo(g.y)), bfhi(v.y) * siluf_(bfhi(g.y)));
        w.z = cvt_pk_bf16(bflo(v.z) * siluf_(bflo(g.z)), bfhi(v.z) * siluf_(bfhi(g.z))); w.w = cvt_pk_bf16(bflo(v.w) * siluf_(bflo(g.w)), bfhi(v.w) * siluf_(bfhi(g.w)));
        *(u32x4*)(Qb + goff) = w;
    }
    __syncthreads();
#undef SLOADA
#undef SLOADB
#undef SWRITEA
#undef SWRITEB
#undef SWAIT
}
}

namespace hg {
constexpr int QRAW = 0, ZRAW = 8192, VRAW = 16384, QT = 24576, KT = QT + 8704, KDT = KT + 8704, DL = KDT + 10240, TOT = DL + 512, OT = TOT + 1024, GROUP_BYTES = OT + 16384;
constexpr int NC = SEQ / 32;
__device__ __forceinline__ int crow(int r, int hi) { return (r & 3) + 8 * (r >> 2) + 4 * hi; }
__device__ __forceinline__ void hgrn_item(char* lds, bf16_t* proj, int bl, int h, const float* lb0, const float* lb1, const float* gw) {
    int tid = threadIdx.x; asm volatile("" : "+v"(tid));
    const int gd = __builtin_amdgcn_readfirstlane(tid >> 8), wv = __builtin_amdgcn_readfirstlane((tid >> 6) & 3);
    const int gt = tid & 255, lane = tid & 63, r32 = lane & 31, hi = lane >> 5;
    char* G = lds + gd * GROUP_BYTES;
    const size_t hb = (size_t)bl * SEQ * 1024 + h * 128;
    bf16_t* HQp = proj + PO_HQ + hb;
    const bf16_t* Zp = proj + (gd ? PO_ZB : PO_ZF) + hb;
    bf16_t* PW = proj + (gd ? PO_ZB : PO_ZF) + hb;
    const bf16_t* PR = proj + (gd ? PO_ZF : PO_ZB) + hb;
    const bf16_t* HIp = proj + PO_HI + hb; const bf16_t* HGp = proj + PO_HG + hb;
    const int k0 = 2 * lane, tg = wv;
    const float lbA = (gd ? lb1 : lb0)[h * 128 + k0], lbB = (gd ? lb1 : lb0)[h * 128 + k0 + 1], omA = 1.0f - lbA, omB = 1.0f - lbB;
    f32x16 sacc[4];
#pragma unroll
    for (int i = 0; i < 4; ++i) sacc[i] = f32x16{};
    unsigned zr[8], qq8[8]; u32x4 pv[2];
    const int prow0 = gt >> 4, pc8 = (gt & 15) * 8;
    const int rfirst = gd ? 31 - 8 * tg : 8 * tg, rstep = gd ? -1 : 1;
#define HG_LOADZ(dst, c) do { _Pragma("unroll") for (int j = 0; j < 8; ++j) dst[j] = *(const unsigned*)(Zp + (size_t)((c) * 32 + rfirst + j * rstep) * 1024 + k0); } while (0)
#define HG_LOAD(dq, dv, c) do { _Pragma("unroll") for (int j = 0; j < 8; ++j) { const size_t go = (size_t)((c) * 32 + rfirst + j * rstep) * 1024 + k0; \
        dq[j] = *(const unsigned*)(HQp + go); } \
        _Pragma("unroll") for (int ii = 0; ii < 2; ++ii) dv[ii] = *(const u32x4*)(HIp + (size_t)((c) * 32 + prow0 + 16 * ii) * 1024 + pc8); } while (0)
    HG_LOADZ(zr, gd ? NC - 1 : 0); HG_LOAD(qq8, pv, gd ? NC - 1 : 0);
    const int i16 = r32 & 15, g16 = r32 >> 4;
    const int vtr = (int)(uintptr_t)(G + VRAW) + (gd ? (7 - 4 * hi - (i16 >> 2)) : (4 * hi + (i16 >> 2))) * 256 + (32 * wv + 16 * g16 + 4 * (i16 & 3)) * 2;
    const int ktr = (int)(uintptr_t)(G + KT) + (4 * hi + (i16 >> 2)) * 272 + (16 * g16 + 4 * (i16 & 3)) * 2;
    const int et = gt >> 3, ec16 = (gt & 7) * 16;
    float gwr[16];
#pragma unroll
    for (int j = 0; j < 16; ++j) gwr[j] = gw[ec16 + j];
    size_t ego = 0; unsigned long long pw[4] = {0, 0, 0, 0}; u32x4 g0 = {0, 0, 0, 0}, g1 = {0, 0, 0, 0};
    float feA[8], feB[8], PlA[8], PlB[8];
    f32x16 mk;
#pragma unroll
    for (int r = 0; r < 16; ++r) mk[r] = (crow(r, hi) <= r32) ? 1.0f : 0.0f;
    for (int i = 0; i <= NC; ++i) {
        if (i > 0) {
            float ov[16];
#pragma unroll
            for (int q4 = 0; q4 < 4; ++q4) { const f32x4 v = *(const f32x4*)(G + OT + (et * 128 + ec16 + 4 * q4) * 4); ov[4 * q4] = v[0]; ov[4 * q4 + 1] = v[1]; ov[4 * q4 + 2] = v[2]; ov[4 * q4 + 3] = v[3]; }
            if (i - 1 < NC / 2) {
                u32x4 w0, w1;
                w0.x = cvt_pk_bf16(ov[0], ov[1]); w0.y = cvt_pk_bf16(ov[2], ov[3]); w0.z = cvt_pk_bf16(ov[4], ov[5]); w0.w = cvt_pk_bf16(ov[6], ov[7]);
                w1.x = cvt_pk_bf16(ov[8], ov[9]); w1.y = cvt_pk_bf16(ov[10], ov[11]); w1.z = cvt_pk_bf16(ov[12], ov[13]); w1.w = cvt_pk_bf16(ov[14], ov[15]);
                *(u32x4*)(PW + ego) = w0; *(u32x4*)(PW + ego + 8) = w1;
                if (i == NC / 2) asm volatile("s_waitcnt vmcnt(0)" ::: "memory");
            } else {
                float ss = 0.f;
#pragma unroll
                for (int q4 = 0; q4 < 4; ++q4) { const unsigned lo = (unsigned)pw[q4], hi2 = (unsigned)(pw[q4] >> 32);
                    ov[4 * q4] += bflo(lo); ov[4 * q4 + 1] += bfhi(lo); ov[4 * q4 + 2] += bflo(hi2); ov[4 * q4 + 3] += bfhi(hi2); }
#pragma unroll
                for (int j = 0; j < 16; ++j) ss += ov[j] * ov[j];
                ss += __shfl_xor(ss, 1); ss += __shfl_xor(ss, 2); ss += __shfl_xor(ss, 4);
                const float rstd = __builtin_amdgcn_rsqf(ss * (1.0f / 128.0f) + EPS);
                const unsigned gg[8] = {g0.x, g0.y, g0.z, g0.w, g1.x, g1.y, g1.z, g1.w};
                unsigned wo[8];
#pragma unroll
                for (int j = 0; j < 8; ++j) { const float a = ov[2 * j] * rstd * gwr[2 * j] * bflo(gg[j]), b = ov[2 * j + 1] * rstd * gwr[2 * j + 1] * bfhi(gg[j]); wo[j] = cvt_pk_bf16(a, b); }
                *(u32x4*)(HQp + ego) = (u32x4){wo[0], wo[1], wo[2], wo[3]}; *(u32x4*)(HQp + ego + 8) = (u32x4){wo[4], wo[5], wo[6], wo[7]};
            }
        }
        if (i == NC) break;
        const int c = gd ? NC - 1 - i : i;
        {
            float PA = 1.0f, PB = 1.0f;
#pragma unroll
            for (int j = 0; j < 8; ++j) {
                const float sA = h2f((unsigned short)(zr[j] & 0xffffu)), sB = h2f((unsigned short)(zr[j] >> 16));
                PA *= lbA + omA * sA; PB *= lbB + omB * sB; PlA[j] = PA; PlB[j] = PB; feA[j] = omA - omA * sA; feB[j] = omB - omB * sB; }
            *(float2*)(G + TOT + (tg * 128 + k0) * 4) = make_float2(PA, PB);
            if (i + 1 < NC) { const int c1 = gd ? c - 1 : c + 1; HG_LOADZ(zr, c1); }
        }
        LDS_BAR();
        {
            float preA = 1.0f, preB = 1.0f, plA = 1.0f, plB = 1.0f;
#pragma unroll
            for (int g4 = 0; g4 < 4; ++g4) { const float2 tt = *(const float2*)(G + TOT + (g4 * 128 + k0) * 4); plA *= tt.x; plB *= tt.y; if (g4 < tg) { preA *= tt.x; preB *= tt.y; } }
#pragma unroll
            for (int j = 0; j < 8; ++j) { const int t = 8 * tg + j;
                const float PtA = preA * PlA[j], PtB = preB * PlB[j];
                const float ktA = feA[j] * __builtin_amdgcn_rcpf(fmaxf(PtA, 1e-30f)), ktB = feB[j] * __builtin_amdgcn_rcpf(fmaxf(PtB, 1e-30f));
                *(unsigned*)(G + QT + t * 272 + k0 * 2) = cvt_pk_bf16(bflo(qq8[j]) * PtA, bfhi(qq8[j]) * PtB);
                *(unsigned*)(G + KT + t * 272 + k0 * 2) = cvt_pk_bf16(ktA, ktB);
            }
            if (tg == 0) *(float2*)(G + DL + k0 * 4) = make_float2(plA, plB);
#pragma unroll
            for (int ii = 0; ii < 2; ++ii) *(u32x4*)(G + VRAW + (prow0 + 16 * ii) * 256 + pc8 * 2) = pv[ii];
            ego = (size_t)(c * 32 + (gd ? 31 - et : et)) * 1024 + ec16;
            if (i >= NC / 2) {
                const unsigned long long* pp = (const unsigned long long*)(PR + ego);
#pragma unroll
                for (int q4 = 0; q4 < 4; ++q4) pw[q4] = __hip_atomic_load(pp + q4, __ATOMIC_RELAXED, __HIP_MEMORY_SCOPE_AGENT);
                g0 = *(const u32x4*)(HGp + ego); g1 = *(const u32x4*)(HGp + ego + 8);
            }
            if (i + 1 < NC) { const int c1 = gd ? c - 1 : c + 1; HG_LOAD(qq8, pv, c1); }
        }
        LDS_BAR();
        {
            s16x4 v00, v01, v10, v11;
            if (gd == 0) {
                asm volatile("ds_read_b64_tr_b16 %0, %1 offset:0" : "=&v"(v00) : "v"(vtr) : "memory"); asm volatile("ds_read_b64_tr_b16 %0, %1 offset:2048" : "=&v"(v01) : "v"(vtr) : "memory");
                asm volatile("ds_read_b64_tr_b16 %0, %1 offset:4096" : "=&v"(v10) : "v"(vtr) : "memory"); asm volatile("ds_read_b64_tr_b16 %0, %1 offset:6144" : "=&v"(v11) : "v"(vtr) : "memory");
            } else {
                asm volatile("ds_read_b64_tr_b16 %0, %1 offset:6144" : "=&v"(v00) : "v"(vtr) : "memory"); asm volatile("ds_read_b64_tr_b16 %0, %1 offset:4096" : "=&v"(v01) : "v"(vtr) : "memory");
                asm volatile("ds_read_b64_tr_b16 %0, %1 offset:2048" : "=&v"(v10) : "v"(vtr) : "memory"); asm volatile("ds_read_b64_tr_b16 %0, %1 offset:0" : "=&v"(v11) : "v"(vtr) : "memory");
            }
            f32x16 X = f32x16{};
#pragma unroll
            for (int ks = 0; ks < 8; ++ks) {
                const bf16x8 a = *(const bf16x8*)(G + KT + r32 * 272 + (16 * ks + 8 * hi) * 2);
                const bf16x8 b = *(const bf16x8*)(G + QT + r32 * 272 + (16 * ks + 8 * hi) * 2);
                X = __builtin_amdgcn_mfma_f32_32x32x16_bf16(a, b, X, 0, 0, 0);
            }
            X = X * mk;
            asm volatile("s_waitcnt lgkmcnt(0)" : "+v"(v00), "+v"(v01), "+v"(v10), "+v"(v11) :: "memory");
            bf16x8 pa[2], vb[2];
            vb[0] = (bf16x8){v00[0], v00[1], v00[2], v00[3], v01[0], v01[1], v01[2], v01[3]};
            vb[1] = (bf16x8){v10[0], v10[1], v10[2], v10[3], v11[0], v11[1], v11[2], v11[3]};
#pragma unroll
            for (int sp = 0; sp < 2; ++sp) {
                u32x4 w; w.x = cvt_pk_bf16(X[8 * sp + 0], X[8 * sp + 1]); w.y = cvt_pk_bf16(X[8 * sp + 2], X[8 * sp + 3]); w.z = cvt_pk_bf16(X[8 * sp + 4], X[8 * sp + 5]); w.w = cvt_pk_bf16(X[8 * sp + 6], X[8 * sp + 7]);
                pa[sp] = __builtin_bit_cast(bf16x8, w);
            }
            f32x16 oacc = f32x16{};
            oacc = __builtin_amdgcn_mfma_f32_32x32x16_bf16(pa[0], vb[0], oacc, 0, 0, 0);
            oacc = __builtin_amdgcn_mfma_f32_32x32x16_bf16(pa[1], vb[1], oacc, 0, 0, 0);
#pragma unroll
            for (int kt = 0; kt < 4; ++kt) {
#pragma unroll
                for (int sp = 0; sp < 2; ++sp) {
                    u32x4 w; w.x = cvt_pk_bf16(sacc[kt][8 * sp + 0], sacc[kt][8 * sp + 1]); w.y = cvt_pk_bf16(sacc[kt][8 * sp + 2], sacc[kt][8 * sp + 3]);
                    w.z = cvt_pk_bf16(sacc[kt][8 * sp + 4], sacc[kt][8 * sp + 5]); w.w = cvt_pk_bf16(sacc[kt][8 * sp + 6], sacc[kt][8 * sp + 7]);
                    const bf16x8 sb = __builtin_bit_cast(bf16x8, w);
                    const s16x4 lo = *(const s16x4*)(G + QT + r32 * 272 + (32 * kt + 16 * sp + 4 * hi) * 2);
                    const s16x4 h4 = *(const s16x4*)(G + QT + r32 * 272 + (32 * kt + 16 * sp + 8 + 4 * hi) * 2);
                    const bf16x8 qa = (bf16x8){lo[0], lo[1], lo[2], lo[3], h4[0], h4[1], h4[2], h4[3]};
                    oacc = __builtin_amdgcn_mfma_f32_32x32x16_bf16(qa, sb, oacc, 0, 0, 0);
                }
            }
#pragma unroll
            for (int kh = 0; kh < 2; ++kh) {
                s16x4 kf[2][2][2];
#pragma unroll
                for (int k2 = 0; k2 < 2; ++k2)
#pragma unroll
                    for (int sp = 0; sp < 2; ++sp)
#pragma unroll
                        for (int pp2 = 0; pp2 < 2; ++pp2) asm volatile("ds_read_b64_tr_b16 %0, %1 offset:%2" : "=&v"(kf[k2][sp][pp2]) : "v"(ktr), "i"(sp * 4352 + pp2 * 2176 + (2 * kh + k2) * 64) : "memory");
                asm volatile("s_waitcnt lgkmcnt(0)" : "+v"(kf[0][0][0]), "+v"(kf[0][0][1]), "+v"(kf[0][1][0]), "+v"(kf[0][1][1]), "+v"(kf[1][0][0]), "+v"(kf[1][0][1]), "+v"(kf[1][1][0]), "+v"(kf[1][1][1]) :: "memory");
#pragma unroll
                for (int k2 = 0; k2 < 2; ++k2) {
                    const int kt = 2 * kh + k2;
#pragma unroll
                    for (int sp = 0; sp < 2; ++sp) {
                        const bf16x8 ka = (bf16x8){kf[k2][sp][0][0], kf[k2][sp][0][1], kf[k2][sp][0][2], kf[k2][sp][0][3], kf[k2][sp][1][0], kf[k2][sp][1][1], kf[k2][sp][1][2], kf[k2][sp][1][3]};
                        sacc[kt] = __builtin_amdgcn_mfma_f32_32x32x16_bf16(ka, vb[sp], sacc[kt], 0, 0, 0);
                    }
#pragma unroll
                    for (int rq = 0; rq < 4; ++rq) { const f32x4 d4 = *(const f32x4*)(G + DL + (32 * kt + 8 * rq + 4 * hi) * 4);
                        sacc[kt][4 * rq + 0] *= d4[0]; sacc[kt][4 * rq + 1] *= d4[1]; sacc[kt][4 * rq + 2] *= d4[2]; sacc[kt][4 * rq + 3] *= d4[3]; }
                }
            }
#pragma unroll
            for (int r = 0; r < 16; ++r) ((float*)(G + OT))[crow(r, hi) * 128 + 32 * wv + r32] = oacc[r];
        }
        LDS_BAR();
    }
#undef HG_LOAD
#undef HG_LOADZ
}
}

__device__ __forceinline__ void transpose_w(const float* __restrict__ W, int K, int N, bf16_t* __restrict__ out, const float* __restrict__ ksc, bool permqk, float* tile  ) {
    const int tid = threadIdx.x, ntn = N / 64, ntk = K / 64, ntiles = ntn * ntk;
    const int lk = tid >> 3, lc = (tid & 7) * 8;
    for (int t = blockIdx.x; t < ntiles; t += gridDim.x) {
        const int n0 = (t % ntn) * 64, k0 = (t / ntn) * 64;
        const float sc = ksc ? ksc[k0 + lk] : 1.0f;
        float v[8];
#pragma unroll
        for (int j = 0; j < 8; ++j) {
            const int nv = n0 + lc + j; int nr = nv;
            if (permqk && nv < 1280) { const int cv = nv & 255; const int bj = cv >> 7, wc = (cv >> 5) & 3, fq = (cv >> 3) & 3, n = (cv >> 2) & 1, e = cv & 3; nr = (nv & ~255) + 64 * wc + 32 * bj + 16 * n + 4 * fq + e; }
            v[j] = W[(size_t)(k0 + lk) * N + nr] * sc;
        }
#pragma unroll
        for (int j = 0; j < 8; ++j) tile[(lc + j) * 65 + lk] = v[j];
        __syncthreads();
        const float* tr = tile + lk * 65 + lc;
        u32x4 w; w.x = cvt_pk_bf16(tr[0], tr[1]); w.y = cvt_pk_bf16(tr[2], tr[3]); w.z = cvt_pk_bf16(tr[4], tr[5]); w.w = cvt_pk_bf16(tr[6], tr[7]);
        *(u32x4*)(out + (size_t)(n0 + lk) * K + k0 + lc) = w;
        __syncthreads();
    }
}
__device__ __forceinline__ void rowprep(const float* __restrict__ x, bf16_t* __restrict__ xb, float* __restrict__ rrow, int gwave, int nwaves, int lane) {
    for (int row = gwave; row < NTOK; row += nwaves) {
        const float* xr = x + (size_t)row * DM; float ss = 0.f; f32x4 v[4];
#pragma unroll
        for (int i = 0; i < 4; ++i) { v[i] = __builtin_nontemporal_load((const f32x4*)(xr + 4 * lane + 256 * i)); const f32x4 q = v[i] * v[i]; ss += (q[0] + q[1]) + (q[2] + q[3]); }
#pragma unroll
        for (int o = 1; o < 64; o <<= 1) ss += __shfl_xor(ss, o);
        const float rn = 1.0f / sqrtf(ss * (1.0f / DM) + EPS);
#pragma unroll
        for (int i = 0; i < 4; ++i) { u32x2 w; w.x = cvt_pk_bf16(v[i][0] * rn, v[i][1] * rn); w.y = cvt_pk_bf16(v[i][2] * rn, v[i][3] * rn); *(u32x2*)(xb + (size_t)row * DM + 4 * lane + 256 * i) = w; }
    }
}
__device__ __forceinline__ void final_norm(float* __restrict__ x, const float* __restrict__ fw, int gwave, int nwaves, int lane) {
    for (int row = gwave; row < NTOK; row += nwaves) {
        float* xr = x + (size_t)row * DM; float ss = 0.f; f32x4 v[4];
#pragma unroll
        for (int i = 0; i < 4; ++i) { v[i] = __builtin_nontemporal_load((const f32x4*)(xr + 4 * lane + 256 * i)); const f32x4 q = v[i] * v[i]; ss += (q[0] + q[1]) + (q[2] + q[3]); }
#pragma unroll
        for (int o = 1; o < 64; o <<= 1) ss += __shfl_xor(ss, o);
        const float r = 1.0f / sqrtf(ss * (1.0f / DM) + EPS);
#pragma unroll
        for (int i = 0; i < 4; ++i) { const f32x4 w = *(const f32x4*)(fw + 4 * lane + 256 * i); __builtin_nontemporal_store(v[i] * r * w, (f32x4*)(xr + 4 * lane + 256 * i)); }
    }
}

#define XB_TMO      128
#define XB_XCNT(j)  (256  + 64 * (j))
#define XB_XSUB(j)  (1280 + 64 * (j))
#define XB_XGEN(j)  (2304 + 64 * (j))
#define XB_TOP      3328
#define XB_TOPGEN   3392
#define XCD_BAR_WORDS 3456
#define XB_SPIN_CAP (1u << 18)
__device__ __forceinline__ unsigned xb_ld(unsigned* p)              { return __hip_atomic_load(p, __ATOMIC_RELAXED, __HIP_MEMORY_SCOPE_AGENT); }
__device__ __forceinline__ unsigned xb_add(unsigned* p, unsigned v) { return __hip_atomic_fetch_add(p, v, __ATOMIC_RELAXED, __HIP_MEMORY_SCOPE_AGENT); }
__device__ __forceinline__ unsigned xb_xcc_id() { return (unsigned)__builtin_amdgcn_s_getreg((3 << 11) | 20) & 0xFu; }
#define XB_SPIN(cond, bar) do { unsigned _sp = 0; while (cond) { __builtin_amdgcn_s_sleep(1); \
    if ((++_sp & 255u) == 0u) { if (xb_ld(&(bar)[XB_TMO])) break; if (_sp > XB_SPIN_CAP) { atomicAdd(&(bar)[XB_TMO], 1u); break; } } } } while (0)
struct XcdBarrier { unsigned* bar; unsigned x; volatile LAS unsigned* st; };
__device__ __forceinline__ void xcd_barrier_post(unsigned* bar) { if (threadIdx.x == 0) (void)xb_add(&bar[XB_XCNT(xb_xcc_id())], 1u); }
__device__ __forceinline__ void xcd_barrier_complete(unsigned* bar, unsigned x, unsigned& nloc, unsigned& nx) {
    const unsigned G = gridDim.x * gridDim.y * gridDim.z;
    unsigned sum, cnt, mine, sp = 0u;
    for (;;) {
        sum = 0u; cnt = 0u; mine = 0u;
#pragma unroll
        for (unsigned j = 0; j < 16; ++j) { const unsigned c = xb_ld(&bar[XB_XCNT(j)]); sum += c; cnt += (c > 0u) ? 1u : 0u; mine = (j == x) ? c : mine; }
        if (sum == G) break;
        __builtin_amdgcn_s_sleep(1);
        if ((++sp & 255u) == 0u) { if (xb_ld(&bar[XB_TMO])) break; if (sp > XB_SPIN_CAP) { atomicAdd(&bar[XB_TMO], 1u); break; } }
    }
    nloc = mine > 0u ? mine : 1u; nx = cnt > 0u ? cnt : 1u;
}
__device__ __forceinline__ void xcd_barrier(const XcdBarrier& b) {
    asm volatile("s_waitcnt vmcnt(0)" ::: "memory");
    __syncthreads();
    if (threadIdx.x == 0) {
        unsigned* bar = b.bar;
        __builtin_amdgcn_s_waitcnt(0);
        unsigned nloc = b.st[0], nx = b.st[1];
        if (nloc == 0u) { xcd_barrier_complete(bar, b.x, nloc, nx); b.st[0] = nloc; b.st[1] = nx; }
        const unsigned old = xb_add(&bar[XB_XSUB(b.x)], 1u);
        const unsigned gen = old / nloc;
        if (old + 1u == (gen + 1u) * nloc) {
            __builtin_amdgcn_fence(__ATOMIC_RELEASE, "agent");
            asm volatile("s_waitcnt vmcnt(0)" ::: "memory");
            const unsigned og = xb_add(&bar[XB_TOP], 1u);
            const unsigned tg = og / nx;
            if (og + 1u == (tg + 1u) * nx) xb_add(&bar[XB_TOPGEN], 1u);
            else XB_SPIN(xb_ld(&bar[XB_TOPGEN]) == tg, bar);
            __builtin_amdgcn_fence(__ATOMIC_ACQUIRE, "agent");
            xb_add(&bar[XB_XGEN(b.x)], 1u);
            asm volatile("s_waitcnt vmcnt(0)" ::: "memory");
        } else {
            XB_SPIN(xb_ld(&bar[XB_XGEN(b.x)]) == gen, bar);
            __builtin_amdgcn_fence(__ATOMIC_ACQUIRE, "agent");
            asm volatile("s_waitcnt vmcnt(0)" ::: "memory");
        }
    }
    __syncthreads();
}

constexpr int ATT_LDS = 3 * att::SHM_V + 3 * att::SHM_K + 8 * 64 * 4;
constexpr int LDS_MAIN = (2 * hg::GROUP_BYTES > pg8::STAGE_BYTES ? 2 * hg::GROUP_BYTES : pg8::STAGE_BYTES);
constexpr int LDS_BYTES = LDS_MAIN + 16;
constexpr size_t WS_BAR = WS_END + 1024, WS_END2 = WS_BAR + XCD_BAR_WORDS * 4;
static_assert(ATT_LDS <= LDS_MAIN, "lds");
#ifndef PH_MASK
#define PH_MASK 31
#endif
#ifndef ATT_UA
#define ATT_UA 12
#endif
constexpr int UA = ATT_UA, UB = 16 - ATT_UA;

__global__ void __launch_bounds__(NTHREADS, 2) fwd_megakernel(Params p) {
    extern __shared__ __attribute__((aligned(16))) unsigned char lds[];
    cg::grid_group grid = cg::this_grid();
    typedef const __attribute__((address_space(4))) Params* KPtr;
    const int G = gridDim.x, c = blockIdx.x;
    volatile LAS unsigned* st = (volatile LAS unsigned*)((LAS unsigned char*)lds + LDS_MAIN);
    if (threadIdx.x < 2) st[threadIdx.x] = 0u;
    { const long gt0 = (long)blockIdx.x * NTHREADS + threadIdx.x; if (gt0 < XCD_BAR_WORDS) __hip_atomic_store((unsigned*)(((KPtr)__builtin_amdgcn_kernarg_segment_ptr())->ws + WS_BAR) + gt0, 0u, __ATOMIC_RELAXED, __HIP_MEMORY_SCOPE_AGENT); }
    __syncthreads();
#define GSYNC() do { XcdBarrier b_; b_.bar = (unsigned*)(KP()->ws + WS_BAR); b_.x = xb_xcc_id(); b_.st = st; xcd_barrier(b_); } while (0)
#define IDS() int tid_ = threadIdx.x; asm volatile("" : "+v"(tid_)); const int lane = tid_ & 63; const long gtid = (long)blockIdx.x * NTHREADS + tid_, gthreads = (long)gridDim.x * NTHREADS; const int gwave = (int)(gtid >> 6), nwaves = (int)(gthreads >> 6); (void)lane; (void)gwave; (void)nwaves;
#define KP() ({ const unsigned long long _a = (unsigned long long)__builtin_amdgcn_kernarg_segment_ptr(); unsigned _lo = __builtin_amdgcn_readfirstlane((unsigned)_a), _hi = __builtin_amdgcn_readfirstlane((unsigned)(_a >> 32)); asm volatile("" : "+s"(_lo), "+s"(_hi)); (KPtr)(((unsigned long long)_hi << 32) | _lo); })
#define WSP(kp, off) ((kp)->ws + (off))
#ifdef PROBE_DUR
#define STAMP(k) do { if ((blockIdx.x == 0 || blockIdx.x == 128) && threadIdx.x == 0) { const unsigned long long now_ = __builtin_amdgcn_s_memrealtime(); \
        unsigned long long* T_ = (unsigned long long*)(KP()->ws + WS_END) + (blockIdx.x ? 16 : 0); T_[k] += now_ - T_[15]; T_[15] = now_; } } while (0)
    if ((blockIdx.x == 0 || blockIdx.x == 128) && threadIdx.x == 0) { unsigned long long* T_ = (unsigned long long*)(KP()->ws + WS_END) + (blockIdx.x ? 16 : 0);
        for (int i_ = 0; i_ < 15; ++i_) T_[i_] = 0; T_[15] = __builtin_amdgcn_s_memrealtime(); }
#else
#define STAMP(k) do { } while (0)
#endif
    { IDS();
    for (int l = 0; l < DEPTH; ++l) {
        KPtr kp = KP();
        transpose_w(kp->w_in + (size_t)l * DM * NIN, DM, NIN, (bf16_t*)WSP(kp, WS_WIN) + (size_t)l * NIN * DM, kp->norm_w + l * DM, true, (float*)lds);
        transpose_w(kp->w_ba + (size_t)l * DM * DM, DM, DM, (bf16_t*)WSP(kp, WS_WA) + (size_t)l * DM * DM, nullptr, false, (float*)lds);
        transpose_w(kp->w_bh + (size_t)l * DM * DM, DM, DM, (bf16_t*)WSP(kp, WS_WH) + (size_t)l * DM * DM, nullptr, false, (float*)lds);
        transpose_w(kp->w_out + (size_t)l * DM * DM, DM, DM, (bf16_t*)WSP(kp, WS_WO) + (size_t)l * DM * DM, nullptr, false, (float*)lds);
    }
    { KPtr kp = KP(); float* TAB = (float*)WSP(kp, WS_TAB);
    if (gtid < 1536) {
        const int pos = (int)(gtid >> 4), i = (int)(gtid & 15);
        const float inv = powf(10000.0f, -(float)i / 16.0f);
        if (pos < 32) { const float a = (float)pos * inv; TAB[TAB_COSR + pos * 16 + i] = cosf(a); TAB[TAB_SINR + pos * 16 + i] = sinf(a); }
        else { const int pc = pos - 32; const float a = (float)pc * inv; TAB[TAB_COSC + pc * 16 + i] = cosf(a); TAB[TAB_SINC + pc * 16 + i] = sinf(a); }
    }
    if (gtid >= 4096 && gtid < 4096 + DEPTH) {
        const int l = (int)(gtid - 4096); float mq = 0.f, mk = 0.f;
        for (int i = 0; i < 64; ++i) { mq = fmaxf(mq, fabsf(kp->q_norm_w[l * 64 + i])); mk = fmaxf(mk, fabsf(kp->k_norm_w[l * 64 + i])); }
        TAB[TAB_M2 + l] = 0.18033688011112042f * 64.0f * mq * mk;
    }
    if (gtid >= 2048 && gtid < 2048 + 2048) {
        const int d = (int)((gtid - 2048) >> 10), k = (int)((gtid - 2048) & 1023);
        const float a0 = kp->lbnd[(size_t)(d * DEPTH + 0) * 1024 + k], a1 = kp->lbnd[(size_t)(d * DEPTH + 1) * 1024 + k];
        const float m = fmaxf(a0, a1), e0 = expf(a0 - m), e1 = expf(a1 - m);
        TAB[TAB_LB + (d * 2 + 0) * 1024 + k] = 0.0f; TAB[TAB_LB + (d * 2 + 1) * 1024 + k] = e1 / (e0 + e1);
    }
    rowprep(kp->x, (bf16_t*)WSP(kp, WS_XB), (float*)WSP(kp, WS_RROW), gwave, nwaves, lane); } }
    grid.sync(); xcd_barrier_post((unsigned*)(KP()->ws + WS_BAR)); STAMP(0);

    for (int layer = 0; layer < DEPTH; ++layer) {
        for (int half = 0; half < 2; ++half) {
            const size_t tok0 = (size_t)half * TH;
#if PH_MASK & 1
            {
                KPtr kp = KP();
                pg8::Gemm g{(const bf16_t*)WSP(kp, WS_XB) + tok0 * DM, (const bf16_t*)WSP(kp, WS_WIN) + (size_t)layer * NIN * DM, nullptr, nullptr, TH, NIN, DM};
                pg8::StaticOrder S; S.init(TH, NIN, G, c);
                EpiProj E{(bf16_t*)WSP(kp, WS_PROJ), (const float*)WSP(kp, WS_RROW) + tok0, (const float*)WSP(kp, WS_TAB), kp->q_norm_w + layer * 64, kp->k_norm_w + layer * 64, half ? 8 : 6};
                pg8::gemm_phase<EpiProj, pg8::StaticOrder>((LAS unsigned char*)lds, g, S, E);
            }
#endif
            GSYNC(); STAMP(1);
            {
                KPtr kp = KP();
                bf16_t* PROJ = (bf16_t*)WSP(kp, WS_PROJ); const float* TAB = (const float*)WSP(kp, WS_TAB);
                const int xcd = c & 7, j = c >> 3;
                const bool light = c < 128;
#if PH_MASK & 2
                if (light) hg::hgrn_item((char*)lds, PROJ, c >> 3, c & 7, TAB + TAB_LB + (0 * 2 + layer) * 1024, TAB + TAB_LB + (1 * 2 + layer) * 1024, kp->hnorm_w + layer * 128);
#endif
                __syncthreads(); STAMP(2);
                const int nun = light ? UB : UA, ubase = light ? 16 * UA + j : (j - 16);
#if PH_MASK & 4
                for (int i = 0; i < nun; ++i) {
                    const int u = ubase + 16 * i, grp = xcd * 8 + (u >> 5), w = u & 31;
                    const int bl = grp >> 2, kvh = grp & 3, head = kvh * 4 + (w & 3), qb = w >> 2;
                    const size_t r0 = (size_t)bl * SEQ;
                    att::attn_unit(PROJ + PO_Q + (r0 + qb * 256) * 1024 + head * 64, PROJ + PO_K + r0 * 256 + kvh * 64, PROJ + PO_V + r0 * 256 + kvh * 64,
                                   PROJ + PO_AG + (r0 + qb * 256) * 1024 + head * 64, TAB[TAB_M2 + layer], (char*)lds);
                }
#endif
                STAMP(3);
            }
            GSYNC(); STAMP(4);
#if PH_MASK & 8
            {
                KPtr kp = KP(); bf16_t* PROJ = (bf16_t*)WSP(kp, WS_PROJ);
                pg8::Gemm g{PROJ + PO_Q, (const bf16_t*)WSP(kp, WS_WA) + (size_t)layer * DM * DM, PROJ + PO_HQ, (const bf16_t*)WSP(kp, WS_WH) + (size_t)layer * DM * DM, TH, DM, DM};
                pg8::TwoPassOrder S; S.S.init(TH, DM, G, c);
                EpiMerge E{PROJ + (half ? PO_MA1 : PO_MA), PROJ + PO_MH};
                pg8::gemm_phase<EpiMerge, pg8::TwoPassOrder>((LAS unsigned char*)lds, g, S, E);
            }
#endif
            GSYNC(); STAMP(5);
#if PH_MASK & 16
            {
                KPtr kp = KP(); bf16_t* PROJ = (bf16_t*)WSP(kp, WS_PROJ);
                pg8::Gemm g{PROJ + (half ? PO_MA1 : PO_MA), (const bf16_t*)WSP(kp, WS_WO) + (size_t)layer * DM * DM, nullptr, nullptr, TH, DM, DM};
                pg8::StaticOrder S; S.init(TH, DM, G, c);
                EpiResid E{(layer == 0 ? kp->x : (const float*)kp->out) + tok0 * DM, kp->out + tok0 * DM};
                pg8::gemm_phase<EpiResid, pg8::StaticOrder>((LAS unsigned char*)lds, g, S, E);
            }
#endif
            if (half == 1) GSYNC();
            STAMP(6);
        }
        if (layer + 1 < DEPTH) { IDS(); KPtr kp = KP(); rowprep(kp->out, (bf16_t*)WSP(kp, WS_XB), (float*)WSP(kp, WS_RROW), gwave, nwaves, lane); GSYNC(); STAMP(7); }
    }
    { IDS(); KPtr kp = KP(); final_norm(kp->out, kp->fnorm_w, gwave, nwaves, lane); }
#ifdef PROBE_DUR
    GSYNC(); STAMP(8);
    if (blockIdx.x == 0) {
        const unsigned long long* T_ = (const unsigned long long*)(KP()->ws + WS_END);
        const unsigned long long dt = T_[PROBE_DUR], nn = T_[PROBE_RVR] / 100;
        float* o_ = KP()->out;
        for (unsigned long long i_ = threadIdx.x; i_ < nn; i_ += NTHREADS) o_[i_ * 64] += 0.1f;
        const unsigned long long t0_ = __builtin_amdgcn_s_memrealtime();
        while (__builtin_amdgcn_s_memrealtime() - t0_ < dt) __builtin_amdgcn_s_sleep(8);
    }
#endif
}

extern "C" void kernel_launch(void* const* d_in, const int* in_sizes, int n_in, void* d_out, int out_size, void* d_ws, size_t ws_size, hipStream_t stream) {
    static int grid_blocks = 0;
    if (grid_blocks == 0) {
        if (n_in != 11 || in_sizes[0] != NTOK * DM || out_size != NTOK * DM || ws_size < WS_END2) {
            fprintf(stderr, "kernel_launch: shape mismatch (n_in %d, in0 %d, out %d, ws %zu, need %zu)\n", n_in, n_in > 0 ? in_sizes[0] : -1, out_size, ws_size, (size_t)WS_END); grid_blocks = -1; return; }
        int dev = 0, cus = 0, per_cu = 0;
        hipGetDevice(&dev); hipDeviceGetAttribute(&cus, hipDeviceAttributeMultiprocessorCount, dev);
        if (hipFuncSetAttribute((const void*)fwd_megakernel, hipFuncAttributeMaxDynamicSharedMemorySize, LDS_BYTES) != hipSuccess) { fprintf(stderr, "kernel_launch: hipFuncSetAttribute failed\n"); grid_blocks = -1; return; }
        hipOccupancyMaxActiveBlocksPerMultiprocessor(&per_cu, (const void*)fwd_megakernel, NTHREADS, LDS_BYTES);
        if (per_cu < 1) { fprintf(stderr, "kernel_launch: occupancy query says %d\n", per_cu); per_cu = 1; }
        (void)hipGetLastError();
        grid_blocks = cus;
    }
    if (grid_blocks < 0) return;
    Params p{};
    p.x = (const float*)d_in[0]; p.w_in = (const float*)d_in[1]; p.norm_w = (const float*)d_in[2]; p.q_norm_w = (const float*)d_in[3]; p.k_norm_w = (const float*)d_in[4];
    p.lbnd = (const float*)d_in[5]; p.hnorm_w = (const float*)d_in[6]; p.w_ba = (const float*)d_in[7]; p.w_bh = (const float*)d_in[8]; p.w_out = (const float*)d_in[9];
    p.fnorm_w = (const float*)d_in[10]; p.out = (float*)d_out; p.ws = (unsigned char*)d_ws;
    void* args[] = {&p};
    hipError_t e = hipLaunchCooperativeKernel((const void*)fwd_megakernel, dim3(grid_blocks), dim3(NTHREADS), args, LDS_BYTES, stream);
    if (e != hipSuccess) fprintf(stderr, "cooperative launch failed: %s (grid %d)\n", hipGetErrorString(e), grid_blocks);
}
```

```cpp
#include <hip/hip_runtime.h>
#include <hip/hip_cooperative_groups.h>
#include <cstdio>
#include <cstdint>
namespace cg = cooperative_groups;

#define LAS __attribute__((address_space(3)))
typedef unsigned short bf16_t;
typedef short bf16x8 __attribute__((ext_vector_type(8)));
typedef short s16x4 __attribute__((ext_vector_type(4)));
typedef float f32x4 __attribute__((ext_vector_type(4)));
typedef float f32x16 __attribute__((ext_vector_type(16)));
typedef unsigned u32x4 __attribute__((ext_vector_type(4)));
typedef unsigned u32x2 __attribute__((ext_vector_type(2)));

constexpr int DM = 1024, SEQ = 2048, BATCH = 32, NTOK = BATCH * SEQ, NIN = 9728, DEPTH = 2;
constexpr int HB = 16, TH = HB * SEQ;
constexpr float EPS = 1e-6f;
constexpr int NTHREADS = 512;

constexpr size_t SZ_WIN = (size_t)NIN * DM * 2, SZ_W1 = (size_t)DM * DM * 2;
constexpr size_t WS_WIN = 0, WS_WA = WS_WIN + 2 * SZ_WIN, WS_WH = WS_WA + 2 * SZ_W1, WS_WO = WS_WH + 2 * SZ_W1;
constexpr size_t WS_XB = WS_WO + 2 * SZ_W1, WS_RROW = WS_XB + (size_t)NTOK * DM * 2, WS_TAB = WS_RROW + (size_t)NTOK * 4;
constexpr int TAB_COSR = 0, TAB_SINR = 512, TAB_COSC = 1024, TAB_SINC = 2048, TAB_LB = 3072, TAB_M2 = 3072 + 2 * 2 * 1024, TAB_FLOATS = TAB_M2 + 64;
constexpr size_t WS_PROJ = (WS_TAB + TAB_FLOATS * 4 + 255) / 256 * 256;
constexpr size_t PO_Q = 0, PO_K = (size_t)TH * 1024, PO_V = (size_t)TH * 1280, PO_AG = (size_t)TH * 1536, PO_HQ = PO_AG + (size_t)TH * 1024,
                 PO_ZF = PO_HQ + (size_t)TH * 1024, PO_ZB = PO_ZF + (size_t)TH * 1024, PO_HI = PO_ZB + (size_t)TH * 1024, PO_HG = PO_HI + (size_t)TH * 1024,
                 PO_MA = PO_HG + (size_t)TH * 1024, PO_MH = PO_MA + (size_t)TH * 1024, PO_MA1 = PO_MH + (size_t)TH * 1024, PO_END = PO_MA1 + (size_t)TH * 1024;
constexpr size_t WS_END = WS_PROJ + PO_END * 2;

struct Params {
    const float* x; const float* w_in; const float* norm_w; const float* q_norm_w; const float* k_norm_w; const float* lbnd; const float* hnorm_w;
    const float* w_ba; const float* w_bh; const float* w_out; const float* fnorm_w; float* out; unsigned char* ws;
};

typedef float f32x2_t __attribute__((ext_vector_type(2))); typedef __bf16 bf16x2_t __attribute__((ext_vector_type(2)));
__device__ __forceinline__ unsigned cvt_pk_bf16(float lo, float hi) { f32x2_t v = {lo, hi}; bf16x2_t b = __builtin_convertvector(v, bf16x2_t); return __builtin_bit_cast(unsigned, b); }
__device__ __forceinline__ unsigned cvt_pk_bf16_asm(float lo, float hi) { unsigned r; asm volatile("v_cvt_pk_bf16_f32 %0, %1, %2" : "=v"(r) : "v"(lo), "v"(hi)); return r; }
__device__ __forceinline__ float bf2f(unsigned short v) { return __uint_as_float((unsigned)v << 16); }
__device__ __forceinline__ float bflo(unsigned w) { return __uint_as_float(w << 16); }
__device__ __forceinline__ float bfhi(unsigned w) { return __uint_as_float(w & 0xffff0000u); }
__device__ __forceinline__ unsigned pack_h2(float a, float b) { _Float16 ha = (_Float16)a, hb = (_Float16)b; return (unsigned)__builtin_bit_cast(unsigned short, ha) | ((unsigned)__builtin_bit_cast(unsigned short, hb) << 16); }
__device__ __forceinline__ float h2f(unsigned short v) { return (float)__builtin_bit_cast(_Float16, v); }
__device__ __forceinline__ float sigmoidf_(float x) { return __builtin_amdgcn_rcpf(1.0f + __expf(-x)); }
__device__ __forceinline__ float siluf_(float x) { return x * __builtin_amdgcn_rcpf(1.0f + __expf(-x)); }
#define LDS_BAR() do { asm volatile("s_waitcnt lgkmcnt(0)" ::: "memory"); __builtin_amdgcn_s_barrier(); asm volatile("" ::: "memory"); } while (0)

#ifdef PROBE_DUR
#define GSTAMP(k) do { if (blockIdx.x == 0 && threadIdx.x == 0) { asm volatile("s_waitcnt vmcnt(0)" ::: "memory"); const unsigned long long now_ = __builtin_amdgcn_s_memrealtime(); \
        unsigned long long* T_ = (unsigned long long*)(((const __attribute__((address_space(4))) Params*)__builtin_amdgcn_kernarg_segment_ptr())->ws + WS_END); T_[k] += now_ - T_[15]; T_[15] = now_; } } while (0)
#else
#define GSTAMP(k) do { } while (0)
#endif
namespace pg8 {
constexpr int BM = 256, BK = 64, HALF = 128, HTB = HALF * BK * 2, STAGE_BYTES = 8 * HTB, NXCD = 8, WGM = 8;
__host__ __device__ __forceinline__ int lds_byte(int r, int c) { const int st = (r >> 4) * 2 + (c >> 5), rr = r & 15, cc = c & 31, ob = rr * 64 + cc * 2; return st * 1024 + (ob ^ (((ob >> 9) & 1) << 5)); }
__host__ __device__ __forceinline__ void stage_rc(int b, int& R, int& C) { const int st = b / 1024, sb = b % 1024, swz = sb ^ (((sb >> 9) & 1) << 5); R = (st >> 1) * 16 + swz / 64; C = (st & 1) * 32 + (swz % 64) / 2; }
__host__ __device__ __forceinline__ int perm32(int rho) { const int n = rho >> 4, i = rho & 15; return 8 * (i >> 2) + 4 * n + (i & 3); }

struct Unit { int pm, pn, z; };
struct Gemm { const bf16_t* A0; const bf16_t* B0; const bf16_t* A1; const bf16_t* B1; int M, N, K; };

struct StaticOrder {
    int nM, nN, nwg, G, c;
    __device__ void init(int M, int N, int G_, int c_) { nM = M / BM; nN = N / BM; nwg = nM * nN; G = G_; c = c_; }
    __device__ bool next(int i, Unit& u) const {
        const long L = (long)i * G + c; if (L >= nwg) return false;
        int wgid = (int)L; { const int q = nwg / NXCD, r = nwg % NXCD, xcd = wgid % NXCD, off = wgid / NXCD; wgid = (xcd < r ? xcd * (q + 1) : r * (q + 1) + (xcd - r) * q) + off; }
        const int nig = WGM * nN, gid = wgid / nig, fm = gid * WGM, gsz = (nM - fm) < WGM ? (nM - fm) : WGM;
        u.pm = fm + ((wgid % nig) % gsz); u.pn = (wgid % nig) / gsz; u.z = 0; return true;
    }
};
struct TwoPassOrder {
    StaticOrder S;
    __device__ bool next(int i, Unit& u) const { if (!S.next(i >> 1, u)) return false; u.z = i & 1; return true; }
};

template <class Epi, class Sched>
__device__ __forceinline__ void gemm_phase(LAS unsigned char* lds, const Gemm g, const Sched& S, const Epi& E) {
    int tid = threadIdx.x; asm volatile("" : "+v"(tid));
    const int wid = __builtin_amdgcn_readfirstlane(tid >> 6), lane = tid & 63, wr = wid >> 2, wc = wid & 3, fr = lane & 15, fq = lane >> 4;
    const int K = g.K, nt = K / BK;
    unsigned voffA[2], voffB[2];
#pragma unroll
    for (int i = 0; i < 2; ++i) { int R, C; stage_rc(tid * 16 + i * 8192, R, C); const int Rb = Epi::PERM ? ((R & ~31) + perm32(R & 31)) : R;
        voffA[i] = (unsigned)(R * K + C) * 2u; voffB[i] = (unsigned)(Rb * K + C) * 2u; }
    const size_t kstep = (size_t)(BK * 2);
    const size_t hstep = (size_t)HALF * K * 2;
    const size_t tstep = 2 * hstep;
    const unsigned ldsw = (unsigned)wid * 1024u;
    const int aoff = lds_byte(wr * 64 + fr, fq * 8), boff = lds_byte(wc * 32 + fr, fq * 8);
#define PG8_SA(b, h) (((b) * 2 + (h)) * HTB)
#define PG8_SB(b, h) ((4 + (b) * 2 + (h)) * HTB)
#define PG8_STAGE(bufoff, gbase, voff) do { _Pragma("unroll") for (int _i = 0; _i < 2; ++_i) \
        __builtin_amdgcn_global_load_lds((const unsigned*)((const char*)(gbase) + (voff)[_i]), (LAS unsigned*)(lds + (bufoff) + ldsw + _i * 8192), 16, 0, 0); } while (0)
#define PG8_LDA(dst, b, h) do { _Pragma("unroll") for (int m = 0; m < 4; ++m) _Pragma("unroll") for (int k = 0; k < 2; ++k) dst[m][k] = *(const LAS bf16x8*)(lds + PG8_SA(b, h) + aoff + m * 2048 + k * 1024); } while (0)
#define PG8_LDB(dst, b, h) do { _Pragma("unroll") for (int n = 0; n < 2; ++n) _Pragma("unroll") for (int k = 0; k < 2; ++k) dst[n][k] = *(const LAS bf16x8*)(lds + PG8_SB(b, h) + boff + n * 2048 + k * 1024); } while (0)
#define PG8_MMA(ai, bj, At, Bt) do { __builtin_amdgcn_s_setprio(1); _Pragma("unroll") for (int m = 0; m < 4; ++m) _Pragma("unroll") for (int n = 0; n < 2; ++n) _Pragma("unroll") for (int k = 0; k < 2; ++k) \
        acc[ai][bj][m][n] = __builtin_amdgcn_mfma_f32_16x16x32_bf16(Bt[n][k], At[m][k], acc[ai][bj][m][n], 0, 0, 0); __builtin_amdgcn_s_setprio(0); } while (0)
#define PG8_WAIT_V(n) asm volatile("s_waitcnt vmcnt(" #n ")" ::: "memory")
#define PG8_WAIT_L(n) asm volatile("s_waitcnt lgkmcnt(" #n ")" ::: "memory")
#define PG8_BAR __builtin_amdgcn_s_barrier()
#define PG8_SCHED __builtin_amdgcn_sched_barrier(0)
    Unit cur, nxt; int ui = 0;
    if (!S.next(0, cur)) return;
    f32x4 acc[2][2][4][2];
#pragma unroll
    for (int a = 0; a < 2; ++a)
#pragma unroll
        for (int b = 0; b < 2; ++b)
#pragma unroll
            for (int m = 0; m < 4; ++m)
#pragma unroll
                for (int n = 0; n < 2; ++n) acc[a][b][m][n] = (f32x4){0.f, 0.f, 0.f, 0.f};
    bf16x8 At[4][2], B0[2][2], B1[2][2];
    const char* cA = (const char*)(cur.z ? g.A1 : g.A0) + (size_t)cur.pm * tstep; const char* cB = (const char*)(cur.z ? g.B1 : g.B0) + (size_t)cur.pn * tstep;
    PG8_STAGE(PG8_SB(0, 0), cB, voffB); PG8_STAGE(PG8_SB(0, 1), cB + hstep, voffB); PG8_STAGE(PG8_SA(0, 0), cA, voffA); PG8_STAGE(PG8_SA(0, 1), cA + hstep, voffA);
    if (wr == 1) PG8_BAR;
    PG8_WAIT_V(2); PG8_BAR;
    PG8_STAGE(PG8_SB(1, 0), cB + kstep, voffB); PG8_STAGE(PG8_SA(1, 0), cA + kstep, voffA); PG8_STAGE(PG8_SB(1, 1), cB + hstep + kstep, voffB);
    PG8_WAIT_V(6); PG8_BAR;
    for (;;) {
        const bool has_next = S.next(ui + 1, nxt);
        const char* nA = has_next ? (const char*)(nxt.z ? g.A1 : g.A0) + (size_t)nxt.pm * tstep : cA; const char* nB = has_next ? (const char*)(nxt.z ? g.B1 : g.B0) + (size_t)nxt.pn * tstep : cB;
        for (int t = 0; t < nt; t += 2) {
            const bool last = (t == nt - 2);
            const char* a1 = cA + (size_t)(t + 1) * kstep;
            const char* a2 = last ? nA : cA + (size_t)(t + 2) * kstep; const char* b2 = last ? nB : cB + (size_t)(t + 2) * kstep;
            const char* a3 = a2 + kstep; const char* b3 = b2 + kstep;
            PG8_LDB(B0, 0, 0); PG8_LDB(B1, 0, 1); PG8_SCHED; PG8_LDA(At, 0, 0); PG8_STAGE(PG8_SA(1, 1), a1 + hstep, voffA);
            PG8_WAIT_V(8); PG8_WAIT_L(0); PG8_BAR; PG8_MMA(0, 0, At, B0); PG8_MMA(0, 1, At, B1); PG8_BAR; PG8_SCHED;
            PG8_LDA(At, 0, 1); PG8_STAGE(PG8_SB(0, 0), b2, voffB); PG8_STAGE(PG8_SB(0, 1), b2 + hstep, voffB); PG8_STAGE(PG8_SA(0, 0), a2, voffA);
            PG8_WAIT_V(8); PG8_WAIT_L(0); PG8_BAR; PG8_MMA(1, 0, At, B0); PG8_MMA(1, 1, At, B1); PG8_BAR; PG8_SCHED;
            PG8_LDB(B0, 1, 0); PG8_LDB(B1, 1, 1); PG8_SCHED; PG8_LDA(At, 1, 0); PG8_STAGE(PG8_SA(0, 1), a2 + hstep, voffA);
            PG8_WAIT_V(8); PG8_WAIT_L(0); PG8_BAR; PG8_MMA(0, 0, At, B0); PG8_MMA(0, 1, At, B1); PG8_BAR; PG8_SCHED;
            PG8_LDA(At, 1, 1); PG8_STAGE(PG8_SB(1, 0), b3, voffB); PG8_STAGE(PG8_SB(1, 1), b3 + hstep, voffB); PG8_STAGE(PG8_SA(1, 0), a3, voffA);
            PG8_WAIT_V(8); PG8_WAIT_L(0); PG8_BAR; PG8_MMA(1, 0, At, B0); PG8_MMA(1, 1, At, B1); PG8_BAR; PG8_SCHED;
        }
        if (wr == 0) PG8_BAR;
        GSTAMP(10);
        E(acc, cur, wr, wc, fr, fq);
        GSTAMP(11);
        if (!has_next) break;
        if (!(Epi::CARRY && cur.z == 0)) {
#pragma unroll
        for (int a = 0; a < 2; ++a)
#pragma unroll
            for (int b = 0; b < 2; ++b)
#pragma unroll
                for (int m = 0; m < 4; ++m)
#pragma unroll
                    for (int n = 0; n < 2; ++n) acc[a][b][m][n] = (f32x4){0.f, 0.f, 0.f, 0.f};
        }
        cur = nxt; cA = nA; cB = nB; ++ui;
        if (wr == 1) PG8_BAR;
    }
    PG8_WAIT_V(0);
    PG8_BAR;
#undef PG8_SA
#undef PG8_SB
#undef PG8_STAGE
#undef PG8_LDA
#undef PG8_LDB
#undef PG8_MMA
#undef PG8_WAIT_V
#undef PG8_WAIT_L
#undef PG8_BAR
#undef PG8_SCHED
}
}

struct EpiProj {
    static constexpr bool PERM = true, CARRY = false;
    bf16_t* proj; const float* rrow; const float* tab; const float* qw; const float* kw; int ma_sg;
    __device__ __forceinline__ void operator()(f32x4 (&acc)[2][2][4][2], const pg8::Unit& u, int wr, int wc, int fr, int fq) const {
        const int pn = u.pn;
        if (pn < 5) {
            const float* nw = (pn < 4) ? qw : kw;
            bf16_t* base = (pn < 4) ? (proj + PO_Q + pn * 256) : (proj + PO_K);
            const int ldc = (pn < 4) ? 1024 : 256;
#pragma unroll
            for (int ai = 0; ai < 2; ++ai)
#pragma unroll
                for (int m = 0; m < 4; ++m) {
                    const int row = u.pm * 256 + ai * 128 + wr * 64 + m * 16 + fr;
                    const int s = row & (SEQ - 1), prow = s >> 6, pcol = s & 63;
                    float ss = 0.f;
#pragma unroll
                    for (int bj = 0; bj < 2; ++bj)
#pragma unroll
                        for (int n = 0; n < 2; ++n) { const f32x4 q = acc[ai][bj][m][n] * acc[ai][bj][m][n]; ss += (q[0] + q[1]) + (q[2] + q[3]); }
                    ss += __shfl_xor(ss, 16); ss += __shfl_xor(ss, 32);
                    const float sc = ((pn < 4) ? 0.18033688011112042f : 1.0f) / sqrtf(ss * (1.0f / 64.0f) + EPS);
#pragma unroll
                    for (int bj = 0; bj < 2; ++bj) {
                        const f32x4 c = *(const f32x4*)(tab + (bj ? TAB_COSC + pcol * 16 : TAB_COSR + prow * 16) + 4 * fq);
                        const f32x4 sn = *(const f32x4*)(tab + (bj ? TAB_SINC + pcol * 16 : TAB_SINR + prow * 16) + 4 * fq);
                        const f32x4 w0 = *(const f32x4*)(nw + 32 * bj + 4 * fq), w1 = *(const f32x4*)(nw + 32 * bj + 16 + 4 * fq);
                        const f32x4 x1 = acc[ai][bj][m][0] * sc * w0, x2 = acc[ai][bj][m][1] * sc * w1;
                        const f32x4 o1 = x1 * c - x2 * sn, o2 = x2 * c + x1 * sn;
                        u32x4 w; w.x = cvt_pk_bf16(o1[0], o1[1]); w.y = cvt_pk_bf16(o1[2], o1[3]); w.z = cvt_pk_bf16(o2[0], o2[1]); w.w = cvt_pk_bf16(o2[2], o2[3]);
                        *(u32x4*)(base + (size_t)row * ldc + wc * 64 + bj * 32 + 8 * fq) = w;
                    }
                    if (m & 1) asm volatile("" ::: "memory");
                }
        } else {
            bf16_t* base; int ldc = 1024; bool f16 = false;
            if (pn == 5) { base = proj + PO_V; ldc = 256; }
            else { const int sg = (pn - 6) >> 2; base = proj + PO_AG + (size_t)(sg == 6 ? ma_sg : sg) * ((size_t)TH * 1024) + ((pn - 6) & 3) * 256; f16 = (sg == 2 || sg == 3); }
            const int col0 = wc * 32 + 8 * fq; const bool hq = (pn >= 10 && pn < 14), hgs = (pn >= 26 && pn < 30);
#pragma unroll
            for (int ai = 0; ai < 2; ++ai)
#pragma unroll
                for (int m = 0; m < 4; ++m) {
                    const int row = u.pm * 256 + ai * 128 + wr * 64 + m * 16 + fr;
                    bf16_t* rowp = base + (size_t)row * ldc + col0;
#pragma unroll
                    for (int bj = 0; bj < 2; ++bj) {
                        f32x4 v0 = acc[ai][bj][m][0], v1 = acc[ai][bj][m][1]; u32x4 w;
                        if (hq) {
#pragma unroll
                            for (int e = 0; e < 4; ++e) { v0[e] = siluf_(v0[e]) * 0.08838834764831845f; v1[e] = siluf_(v1[e]) * 0.08838834764831845f; } }
                        if (hgs) {
#pragma unroll
                            for (int e = 0; e < 4; ++e) { v0[e] = siluf_(v0[e]); v1[e] = siluf_(v1[e]); } }
                        if (f16) {
#pragma unroll
                            for (int e = 0; e < 4; ++e) { v0[e] = __builtin_amdgcn_rcpf(1.0f + __builtin_amdgcn_exp2f(v0[e])); v1[e] = __builtin_amdgcn_rcpf(1.0f + __builtin_amdgcn_exp2f(v1[e])); } }
                        if (f16) { w.x = pack_h2(v0[0], v0[1]); w.y = pack_h2(v0[2], v0[3]); w.z = pack_h2(v1[0], v1[1]); w.w = pack_h2(v1[2], v1[3]); }
                        else { w.x = cvt_pk_bf16(v0[0], v0[1]); w.y = cvt_pk_bf16(v0[2], v0[3]); w.z = cvt_pk_bf16(v1[0], v1[1]); w.w = cvt_pk_bf16(v1[2], v1[3]); }
                        *(u32x4*)(rowp + bj * 128) = w;
                    }
                }
        }
    }
};
struct EpiMerge {
    static constexpr bool PERM = true, CARRY = true;
    bf16_t* MA; const bf16_t* MH;
    __device__ __forceinline__ void operator()(f32x4 (&acc)[2][2][4][2], const pg8::Unit& u, int wr, int wc, int fr, int fq) const {
        const int col0 = u.pn * 256 + wc * 32 + 8 * fq;
#pragma unroll
        for (int ai = 0; ai < 2; ++ai)
#pragma unroll
            for (int m = 0; m < 4; ++m) {
                const int row = u.pm * 256 + ai * 128 + wr * 64 + m * 16 + fr;
#pragma unroll
                for (int bj = 0; bj < 2; ++bj) {
                    const size_t off = (size_t)row * 1024 + col0 + bj * 128;
                    const u32x4 g = *(const u32x4*)(MH + off);
                    const unsigned gw[4] = {g.x, g.y, g.z, g.w};
                    if (u.z == 0) {
                        const u32x4 a = *(const u32x4*)(MA + off);
                        const unsigned aw[4] = {a.x, a.y, a.z, a.w};
#pragma unroll
                        for (int q = 0; q < 4; ++q) {
                            const float r0 = (1.0f + __expf(-bflo(gw[q]))) * __builtin_amdgcn_rcpf(1.0f + __expf(-bflo(aw[q])));
                            const float r1 = (1.0f + __expf(-bfhi(gw[q]))) * __builtin_amdgcn_rcpf(1.0f + __expf(-bfhi(aw[q])));
                            acc[ai][bj][m][q >> 1][2 * (q & 1)] *= r0; acc[ai][bj][m][q >> 1][2 * (q & 1) + 1] *= r1;
                        }
                    } else {
                        float r[8];
#pragma unroll
                        for (int q = 0; q < 4; ++q) { r[2 * q] = sigmoidf_(bflo(gw[q])) * acc[ai][bj][m][q >> 1][2 * (q & 1)]; r[2 * q + 1] = sigmoidf_(bfhi(gw[q])) * acc[ai][bj][m][q >> 1][2 * (q & 1) + 1]; }
                        u32x4 w; w.x = cvt_pk_bf16(r[0], r[1]); w.y = cvt_pk_bf16(r[2], r[3]); w.z = cvt_pk_bf16(r[4], r[5]); w.w = cvt_pk_bf16(r[6], r[7]);
                        *(u32x4*)(MA + off) = w;
                    }
                }
                if (m == 3) asm volatile("" ::: "memory");
            }
    }
};
struct EpiResid {
    static constexpr bool PERM = false, CARRY = false;
    const float* xin; float* out;
    __device__ __forceinline__ void operator()(f32x4 (&acc)[2][2][4][2], const pg8::Unit& u, int wr, int wc, int fr, int fq) const {
        const int col0 = u.pn * 256 + wc * 32 + 4 * fq;
#pragma unroll
        for (int ai = 0; ai < 2; ++ai)
#pragma unroll
            for (int m = 0; m < 4; ++m) {
                const size_t off = (size_t)(u.pm * 256 + ai * 128 + wr * 64 + m * 16 + fr) * 1024 + col0;
#pragma unroll
                for (int bj = 0; bj < 2; ++bj)
#pragma unroll
                    for (int n = 0; n < 2; ++n) { const f32x4 b = *(const f32x4*)(xin + off + bj * 128 + n * 16); *(f32x4*)(out + off + bj * 128 + n * 16) = b + acc[ai][bj][m][n]; }
                if (m == 3) asm volatile("" ::: "memory");
            }
    }
};

namespace att {
constexpr int QBLK = 32, KVBLK = 64, LDQ = 1024, LDK = 256;
constexpr float SCALE = 0.125f, THR = 8.f;
constexpr int SHM_V = 8192, SHM_K = 8192;
__device__ __forceinline__ int crow(int r, int hi) { return (r & 3) + 8 * (r >> 2) + 4 * hi; }
#define SBAR() __builtin_amdgcn_sched_barrier(0)
__device__ __forceinline__ void partialSM(f32x16& p0) {
#pragma unroll
    for (int r = 0; r < 16; ++r) p0[r] = __builtin_amdgcn_exp2f(p0[r]);
}
__device__ __forceinline__ void finishSM(f32x16& p0, f32x16& p1, bf16x8& pa0, bf16x8& pa1, bf16x8& pa2, bf16x8& pa3) {
#pragma unroll
    for (int r = 0; r < 16; ++r) p1[r] = __builtin_amdgcn_exp2f(p1[r]);
#define PK4(P, BASE, OUT) do { unsigned a0 = cvt_pk_bf16(P[BASE + 0], P[BASE + 1]), a1 = cvt_pk_bf16(P[BASE + 2], P[BASE + 3]);   \
    unsigned b0 = cvt_pk_bf16(P[BASE + 4], P[BASE + 5]), b1 = cvt_pk_bf16(P[BASE + 6], P[BASE + 7]);                              \
    auto r0 = __builtin_amdgcn_permlane32_swap(a0, b0, false, false); auto r1 = __builtin_amdgcn_permlane32_swap(a1, b1, false, false); \
    u32x4 w = {r0[0], r1[0], r0[1], r1[1]}; OUT = *reinterpret_cast<bf16x8*>(&w); } while (0)
    PK4(p0, 0, pa0); PK4(p0, 8, pa1); PK4(p1, 0, pa2); PK4(p1, 8, pa3);
#undef PK4
}
__device__ __forceinline__ void qkt(f32x16& p0, f32x16& p1, const char* Ks, const bf16x8* qr, const f32x16& negm, int r32, int hi) {
    p0 = negm; p1 = negm;
#pragma unroll
    for (int d0 = 0; d0 < 4; ++d0) {
        const bf16x8 b0 = *reinterpret_cast<const bf16x8*>(Ks + (2 * d0 + hi) * 1024 + r32 * 16);
        const bf16x8 b1 = *reinterpret_cast<const bf16x8*>(Ks + (2 * d0 + hi) * 1024 + 512 + r32 * 16);
        p0 = __builtin_amdgcn_mfma_f32_32x32x16_bf16(b0, qr[d0], p0, 0, 0, 0);
        p1 = __builtin_amdgcn_mfma_f32_32x32x16_bf16(b1, qr[d0], p1, 0, 0, 0); }
}
__device__ __forceinline__ int v_st(int k, int c) { const int kk = (k & ~0xC) | ((k & 4) << 1) | ((k & 8) >> 1); return ((kk >> 3) * 2 + (c >> 5)) * 512 + ((kk & 7) * 32 + (c & 31)) * 2; }
__device__ __forceinline__ int v_rd_base(int lane) { return ((lane & 3) << 3) | (((lane >> 2) & 3) << 6) | (((lane >> 4) & 1) << 5) | (((lane >> 5) & 1) << 8); }
constexpr int v_rd_off(int d0, int ks, int half) { return d0 * 512 + ks * 2048 + half * 1024; }
template <int OFF> __device__ __forceinline__ s16x4 tr_read(int vb) { s16x4 r; asm volatile("ds_read_b64_tr_b16 %0, %1 offset:%2" : "=&v"(r) : "v"(vb), "i"(OFF) : "memory"); return r; }
template <int D0> __device__ __forceinline__ void pv_one(f32x16& od, int vb, bf16x8 pa0, bf16x8 pa1, bf16x8 pa2, bf16x8 pa3) {
    const s16x4 l0 = tr_read<v_rd_off(D0, 0, 0)>(vb), h0 = tr_read<v_rd_off(D0, 0, 1)>(vb), l1 = tr_read<v_rd_off(D0, 1, 0)>(vb), h1 = tr_read<v_rd_off(D0, 1, 1)>(vb);
    const s16x4 l2 = tr_read<v_rd_off(D0, 2, 0)>(vb), h2 = tr_read<v_rd_off(D0, 2, 1)>(vb), l3 = tr_read<v_rd_off(D0, 3, 0)>(vb), h3 = tr_read<v_rd_off(D0, 3, 1)>(vb);
    asm volatile("s_waitcnt lgkmcnt(0)" ::: "memory"); SBAR();
#define PK(L, H) (bf16x8){L[0], L[1], L[2], L[3], H[0], H[1], H[2], H[3]}
    od = __builtin_amdgcn_mfma_f32_32x32x16_bf16(pa0, PK(l0, h0), od, 0, 0, 0);
    od = __builtin_amdgcn_mfma_f32_32x32x16_bf16(pa1, PK(l1, h1), od, 0, 0, 0);
    od = __builtin_amdgcn_mfma_f32_32x32x16_bf16(pa2, PK(l2, h2), od, 0, 0, 0);
    od = __builtin_amdgcn_mfma_f32_32x32x16_bf16(pa3, PK(l3, h3), od, 0, 0, 0);
#undef PK
}
__device__ __forceinline__ void pv_d0(f32x16* o, f32x16& lacc, int vb, bf16x8 pa0, bf16x8 pa1, bf16x8 pa2, bf16x8 pa3) {
    const bf16x8 ones = (bf16x8){0x3F80, 0x3F80, 0x3F80, 0x3F80, 0x3F80, 0x3F80, 0x3F80, 0x3F80};
    pv_one<0>(o[0], vb, pa0, pa1, pa2, pa3);
    lacc = __builtin_amdgcn_mfma_f32_32x32x16_bf16(pa0, ones, lacc, 0, 0, 0);
    lacc = __builtin_amdgcn_mfma_f32_32x32x16_bf16(pa1, ones, lacc, 0, 0, 0);
    pv_one<1>(o[1], vb, pa0, pa1, pa2, pa3);
    lacc = __builtin_amdgcn_mfma_f32_32x32x16_bf16(pa2, ones, lacc, 0, 0, 0);
    lacc = __builtin_amdgcn_mfma_f32_32x32x16_bf16(pa3, ones, lacc, 0, 0, 0);
}

__device__ __forceinline__ void attn_unit(bf16_t* Qb, const bf16_t* __restrict__ Kh, const bf16_t* __restrict__ Vh, const bf16_t* __restrict__ Gb, float m2, char* lds) {
    int tid = threadIdx.x; asm volatile("" : "+v"(tid));
    const int wid = tid >> 6, lane = tid & 63, r32 = lane & 31, hi = lane >> 5;
    char* V_lds = lds; char* K_lds = lds + 3 * SHM_V;
    float* ws = (float*)(lds + 3 * SHM_V + 3 * SHM_K) + wid * 64; float* li_l = ws;
    f32x16 lacc = {}; f32x16 o[2] = {}; bf16x8 qr[4];
    f32x16 negm;
#pragma unroll
    for (int r = 0; r < 16; ++r) negm[r] = -m2;
    const bf16_t* Qw = Qb + (size_t)(wid * QBLK + r32) * LDQ + hi * 8;
#pragma unroll
    for (int d0 = 0; d0 < 4; ++d0) qr[d0] = *reinterpret_cast<const bf16x8*>(Qw + d0 * 16);
    const int krow = tid & 63, kch = tid >> 6, kst = kch * 1024 + krow * 16;
    const int sr = tid >> 3, sc = (tid & 7) * 8, vst0 = v_st(sr, sc);
    const int vb0 = (int)(uintptr_t)V_lds + v_rd_base(lane);
    bf16x8 svA, skA, svB, skB;
#define SLOADA(k0) do { svA = *reinterpret_cast<const bf16x8*>(&Vh[(size_t)((k0) + sr) * LDK + sc]); skA = *reinterpret_cast<const bf16x8*>(&Kh[(size_t)((k0) + krow) * LDK + kch * 8]); } while (0)
#define SLOADB(k0) do { svB = *reinterpret_cast<const bf16x8*>(&Vh[(size_t)((k0) + sr) * LDK + sc]); skB = *reinterpret_cast<const bf16x8*>(&Kh[(size_t)((k0) + krow) * LDK + kch * 8]); } while (0)
#define SWRITEA(bo) do { *(bf16x8*)(V_lds + (bo) + vst0) = svA; *(bf16x8*)(K_lds + (bo) + kst) = skA; } while (0)
#define SWRITEB(bo) do { *(bf16x8*)(V_lds + (bo) + vst0) = svB; *(bf16x8*)(K_lds + (bo) + kst) = skB; } while (0)
    f32x16 pA0, pA1, pB0, pB1; bf16x8 pa0, pa1, pa2, pa3; constexpr int NT = SEQ / KVBLK;
    static_assert(SHM_V == SHM_K, "one rotating offset serves both rings");
    SLOADA(0); SLOADB(KVBLK); asm volatile("s_waitcnt vmcnt(2)" ::: "memory"); SWRITEA(0); SLOADA(2 * KVBLK); __syncthreads();
    SWRITEB(SHM_V); SLOADB(3 * KVBLK);
    qkt(pA0, pA1, K_lds, qr, negm, r32, hi); partialSM(pA0);
    __syncthreads();
    int bp = 0, bc = SHM_V, bn = 2 * SHM_V;
#define ROT3() do { const int t_ = bp; bp = bc; bc = bn; bn = t_; } while (0)
#define STEP_ODD(j) do { \
        SBAR(); qkt(pB0, pB1, K_lds + bc, qr, negm, r32, hi); \
        finishSM(pA0, pA1, pa0, pa1, pa2, pa3); SBAR(); \
        if ((j) + 1 < NT) SWRITEA(bn); \
        if ((j) + 3 < NT) SLOADA(((j) + 3) * KVBLK); SBAR(); \
        pv_d0(o, lacc, vb0 + bp, pa0, pa1, pa2, pa3); partialSM(pB0); \
        __syncthreads(); ROT3(); } while (0)
#define STEP_EVEN(j) do { \
        SBAR(); qkt(pA0, pA1, K_lds + bc, qr, negm, r32, hi); \
        finishSM(pB0, pB1, pa0, pa1, pa2, pa3); SBAR(); \
        if ((j) + 1 < NT) SWRITEB(bn); \
        if ((j) + 3 < NT) SLOADB(((j) + 3) * KVBLK); SBAR(); \
        pv_d0(o, lacc, vb0 + bp, pa0, pa1, pa2, pa3); partialSM(pA0); \
        __syncthreads(); ROT3(); } while (0)
    for (int j = 1; j + 1 < NT; j += 2) { STEP_ODD(j); STEP_EVEN(j + 1); }
    STEP_ODD(NT - 1);
    finishSM(pB0, pB1, pa0, pa1, pa2, pa3); SBAR();
    pv_d0(o, lacc, vb0 + bp, pa0, pa1, pa2, pa3);
#undef STEP_ODD
#undef STEP_EVEN
#undef ROT3
    float rli[16];
#pragma unroll
    for (int r = 0; r < 16; ++r) rli[r] = __builtin_amdgcn_rcpf(lacc[r]);
    __syncthreads();
    bf16_t* stg = (bf16_t*)lds + wid * 2048;
#pragma unroll
    for (int r = 0; r < 16; ++r) { const int orow = crow(r, hi);
#pragma unroll
        for (int d0 = 0; d0 < 2; ++d0) stg[orow * 64 + d0 * 32 + r32] = (bf16_t)(cvt_pk_bf16(o[d0][r] * rli[r], 0.f) & 0xffffu); }
    asm volatile("s_waitcnt lgkmcnt(0)" ::: "memory");
#pragma unroll
    for (int i = 0; i < 4; ++i) {
        const int row = i * 8 + (lane >> 3), ch = lane & 7;
        const u32x4 v = *(const u32x4*)(stg + row * 64 + ch * 8);
        const size_t goff = (size_t)(wid * QBLK + row) * LDQ + ch * 8;
        const u32x4 g = *(const u32x4*)(Gb + goff);
        u32x4 w;
        w.x = cvt_pk_bf16(bflo(v.x) * siluf_(bflo(g.x)), bfhi(v.x) * siluf_(bfhi(g.x))); w.y = cvt_pk_bf16(bflo(v.y) * siluf_(bflo(g.y)), bfhi(v.y) * siluf_(bfhi(g.y)));
        w.z = cvt_pk_bf16(bflo(v.z) * siluf_(bflo(g.z)), bfhi(v.z) * siluf_(bfhi(g.z))); w.w = cvt_pk_bf16(bflo(v.w) * siluf_(bflo(g.w)), bfhi(v.w) * siluf_(bfhi(g.w)));
        *(u32x4*)(Qb + goff) = w;
    }
    __syncthreads();
#undef SLOADA
#undef SLOADB
#undef SWRITEA
#undef SWRITEB
#undef SWAIT
}
}

namespace hg {
constexpr int QRAW = 0, ZRAW = 8192, VRAW = 16384, QT = 24576, KT = QT + 8704, KDT = KT + 8704, DL = KDT + 10240, TOT = DL + 512, OT = TOT + 1024, GROUP_BYTES = OT + 16384;
constexpr int NC = SEQ / 32;
__device__ __forceinline__ int crow(int r, int hi) { return (r & 3) + 8 * (r >> 2) + 4 * hi; }
__device__ __forceinline__ void hgrn_item(char* lds, bf16_t* proj, int bl, int h, const float* lb0, const float* lb1, const float* gw) {
    int tid = threadIdx.x; asm volatile("" : "+v"(tid));
    const int gd = __builtin_amdgcn_readfirstlane(tid >> 8), wv = __builtin_amdgcn_readfirstlane((tid >> 6) & 3);
    const int gt = tid & 255, lane = tid & 63, r32 = lane & 31, hi = lane >> 5;
    char* G = lds + gd * GROUP_BYTES;
    const size_t hb = (size_t)bl * SEQ * 1024 + h * 128;
    bf16_t* HQp = proj + PO_HQ + hb;
    const bf16_t* Zp = proj + (gd ? PO_ZB : PO_ZF) + hb;
    bf16_t* PW = proj + (gd ? PO_ZB : PO_ZF) + hb;
    const bf16_t* PR = proj + (gd ? PO_ZF : PO_ZB) + hb;
    const bf16_t* HIp = proj + PO_HI + hb; const bf16_t* HGp = proj + PO_HG + hb;
    const int k0 = 2 * lane, tg = wv;
    const float lbA = (gd ? lb1 : lb0)[h * 128 + k0], lbB = (gd ? lb1 : lb0)[h * 128 + k0 + 1], omA = 1.0f - lbA, omB = 1.0f - lbB;
    f32x16 sacc[4];
#pragma unroll
    for (int i = 0; i < 4; ++i) sacc[i] = f32x16{};
    unsigned zr[8], qq8[8]; u32x4 pv[2];
    const int prow0 = gt >> 4, pc8 = (gt & 15) * 8;
    const int rfirst = gd ? 31 - 8 * tg : 8 * tg, rstep = gd ? -1 : 1;
#define HG_LOADZ(dst, c) do { _Pragma("unroll") for (int j = 0; j < 8; ++j) dst[j] = *(const unsigned*)(Zp + (size_t)((c) * 32 + rfirst + j * rstep) * 1024 + k0); } while (0)
#define HG_LOAD(dq, dv, c) do { _Pragma("unroll") for (int j = 0; j < 8; ++j) { const size_t go = (size_t)((c) * 32 + rfirst + j * rstep) * 1024 + k0; \
        dq[j] = *(const unsigned*)(HQp + go); } \
        _Pragma("unroll") for (int ii = 0; ii < 2; ++ii) dv[ii] = *(const u32x4*)(HIp + (size_t)((c) * 32 + prow0 + 16 * ii) * 1024 + pc8); } while (0)
    HG_LOADZ(zr, gd ? NC - 1 : 0); HG_LOAD(qq8, pv, gd ? NC - 1 : 0);
    const int i16 = r32 & 15, g16 = r32 >> 4;
    const int vtr = (int)(uintptr_t)(G + VRAW) + (gd ? (7 - 4 * hi - (i16 >> 2)) : (4 * hi + (i16 >> 2))) * 256 + (32 * wv + 16 * g16 + 4 * (i16 & 3)) * 2;
    const int ktr = (int)(uintptr_t)(G + KT) + (4 * hi + (i16 >> 2)) * 272 + (16 * g16 + 4 * (i16 & 3)) * 2;
    const int et = gt >> 3, ec16 = (gt & 7) * 16;
    float gwr[16];
#pragma unroll
    for (int j = 0; j < 16; ++j) gwr[j] = gw[ec16 + j];
    size_t ego = 0; unsigned long long pw[4] = {0, 0, 0, 0}; u32x4 g0 = {0, 0, 0, 0}, g1 = {0, 0, 0, 0};
    float feA[8], feB[8], PlA[8], PlB[8];
    f32x16 mk;
#pragma unroll
    for (int r = 0; r < 16; ++r) mk[r] = (crow(r, hi) <= r32) ? 1.0f : 0.0f;
    for (int i = 0; i <= NC; ++i) {
        if (i > 0) {
            float ov[16];
#pragma unroll
            for (int q4 = 0; q4 < 4; ++q4) { const f32x4 v = *(const f32x4*)(G + OT + (et * 128 + ec16 + 4 * q4) * 4); ov[4 * q4] = v[0]; ov[4 * q4 + 1] = v[1]; ov[4 * q4 + 2] = v[2]; ov[4 * q4 + 3] = v[3]; }
            if (i - 1 < NC / 2) {
                u32x4 w0, w1;
                w0.x = cvt_pk_bf16(ov[0], ov[1]); w0.y = cvt_pk_bf16(ov[2], ov[3]); w0.z = cvt_pk_bf16(ov[4], ov[5]); w0.w = cvt_pk_bf16(ov[6], ov[7]);
                w1.x = cvt_pk_bf16(ov[8], ov[9]); w1.y = cvt_pk_bf16(ov[10], ov[11]); w1.z = cvt_pk_bf16(ov[12], ov[13]); w1.w = cvt_pk_bf16(ov[14], ov[15]);
                *(u32x4*)(PW + ego) = w0; *(u32x4*)(PW + ego + 8) = w1;
                if (i == NC / 2) asm volatile("s_waitcnt vmcnt(0)" ::: "memory");
            } else {
                float ss = 0.f;
#pragma unroll
                for (int q4 = 0; q4 < 4; ++q4) { const unsigned lo = (unsigned)pw[q4], hi2 = (unsigned)(pw[q4] >> 32);
                    ov[4 * q4] += bflo(lo); ov[4 * q4 + 1] += bfhi(lo); ov[4 * q4 + 2] += bflo(hi2); ov[4 * q4 + 3] += bfhi(hi2); }
#pragma unroll
                for (int j = 0; j < 16; ++j) ss += ov[j] * ov[j];
                ss += __shfl_xor(ss, 1); ss += __shfl_xor(ss, 2); ss += __shfl_xor(ss, 4);
                const float rstd = __builtin_amdgcn_rsqf(ss * (1.0f / 128.0f) + EPS);
                const unsigned gg[8] = {g0.x, g0.y, g0.z, g0.w, g1.x, g1.y, g1.z, g1.w};
                unsigned wo[8];
#pragma unroll
                for (int j = 0; j < 8; ++j) { const float a = ov[2 * j] * rstd * gwr[2 * j] * bflo(gg[j]), b = ov[2 * j + 1] * rstd * gwr[2 * j + 1] * bfhi(gg[j]); wo[j] = cvt_pk_bf16(a, b); }
                *(u32x4*)(HQp + ego) = (u32x4){wo[0], wo[1], wo[2], wo[3]}; *(u32x4*)(HQp + ego + 8) = (u32x4){wo[4], wo[5], wo[6], wo[7]};
            }
        }
        if (i == NC) break;
        const int c = gd ? NC - 1 - i : i;
        {
            float PA = 1.0f, PB = 1.0f;
#pragma unroll
            for (int j = 0; j < 8; ++j) {
                const float sA = h2f((unsigned short)(zr[j] & 0xffffu)), sB = h2f((unsigned short)(zr[j] >> 16));
                PA *= lbA + omA * sA; PB *= lbB + omB * sB; PlA[j] = PA; PlB[j] = PB; feA[j] = omA - omA * sA; feB[j] = omB - omB * sB; }
            *(float2*)(G + TOT + (tg * 128 + k0) * 4) = make_float2(PA, PB);
            if (i + 1 < NC) { const int c1 = gd ? c - 1 : c + 1; HG_LOADZ(zr, c1); }
        }
        LDS_BAR();
        {
            float preA = 1.0f, preB = 1.0f, plA = 1.0f, plB = 1.0f;
#pragma unroll
            for (int g4 = 0; g4 < 4; ++g4) { const float2 tt = *(const float2*)(G + TOT + (g4 * 128 + k0) * 4); plA *= tt.x; plB *= tt.y; if (g4 < tg) { preA *= tt.x; preB *= tt.y; } }
#pragma unroll
            for (int j = 0; j < 8; ++j) { const int t = 8 * tg + j;
                const float PtA = preA * PlA[j], PtB = preB * PlB[j];
                const float ktA = feA[j] * __builtin_amdgcn_rcpf(fmaxf(PtA, 1e-30f)), ktB = feB[j] * __builtin_amdgcn_rcpf(fmaxf(PtB, 1e-30f));
                *(unsigned*)(G + QT + t * 272 + k0 * 2) = cvt_pk_bf16(bflo(qq8[j]) * PtA, bfhi(qq8[j]) * PtB);
                *(unsigned*)(G + KT + t * 272 + k0 * 2) = cvt_pk_bf16(ktA, ktB);
            }
            if (tg == 0) *(float2*)(G + DL + k0 * 4) = make_float2(plA, plB);
#pragma unroll
            for (int ii = 0; ii < 2; ++ii) *(u32x4*)(G + VRAW + (prow0 + 16 * ii) * 256 + pc8 * 2) = pv[ii];
            ego = (size_t)(c * 32 + (gd ? 31 - et : et)) * 1024 + ec16;
            if (i >= NC / 2) {
                const unsigned long long* pp = (const unsigned long long*)(PR + ego);
#pragma unroll
                for (int q4 = 0; q4 < 4; ++q4) pw[q4] = __hip_atomic_load(pp + q4, __ATOMIC_RELAXED, __HIP_MEMORY_SCOPE_AGENT);
                g0 = *(const u32x4*)(HGp + ego); g1 = *(const u32x4*)(HGp + ego + 8);
            }
            if (i + 1 < NC) { const int c1 = gd ? c - 1 : c + 1; HG_LOAD(qq8, pv, c1); }
        }
        LDS_BAR();
        {
            s16x4 v00, v01, v10, v11;
            if (gd == 0) {
                asm volatile("ds_read_b64_tr_b16 %0, %1 offset:0" : "=&v"(v00) : "v"(vtr) : "memory"); asm volatile("ds_read_b64_tr_b16 %0, %1 offset:2048" : "=&v"(v01) : "v"(vtr) : "memory");
                asm volatile("ds_read_b64_tr_b16 %0, %1 offset:4096" : "=&v"(v10) : "v"(vtr) : "memory"); asm volatile("ds_read_b64_tr_b16 %0, %1 offset:6144" : "=&v"(v11) : "v"(vtr) : "memory");
            } else {
                asm volatile("ds_read_b64_tr_b16 %0, %1 offset:6144" : "=&v"(v00) : "v"(vtr) : "memory"); asm volatile("ds_read_b64_tr_b16 %0, %1 offset:4096" : "=&v"(v01) : "v"(vtr) : "memory");
                asm volatile("ds_read_b64_tr_b16 %0, %1 offset:2048" : "=&v"(v10) : "v"(vtr) : "memory"); asm volatile("ds_read_b64_tr_b16 %0, %1 offset:0" : "=&v"(v11) : "v"(vtr) : "memory");
            }
            f32x16 X = f32x16{};
#pragma unroll
            for (int ks = 0; ks < 8; ++ks) {
                const bf16x8 a = *(const bf16x8*)(G + KT + r32 * 272 + (16 * ks + 8 * hi) * 2);
                const bf16x8 b = *(const bf16x8*)(G + QT + r32 * 272 + (16 * ks + 8 * hi) * 2);
                X = __builtin_amdgcn_mfma_f32_32x32x16_bf16(a, b, X, 0, 0, 0);
            }
            X = X * mk;
            asm volatile("s_waitcnt lgkmcnt(0)" : "+v"(v00), "+v"(v01), "+v"(v10), "+v"(v11) :: "memory");
            bf16x8 pa[2], vb[2];
            vb[0] = (bf16x8){v00[0], v00[1], v00[2], v00[3], v01[0], v01[1], v01[2], v01[3]};
            vb[1] = (bf16x8){v10[0], v10[1], v10[2], v10[3], v11[0], v11[1], v11[2], v11[3]};
#pragma unroll
            for (int sp = 0; sp < 2; ++sp) {
                u32x4 w; w.x = cvt_pk_bf16(X[8 * sp + 0], X[8 * sp + 1]); w.y = cvt_pk_bf16(X[8 * sp + 2], X[8 * sp + 3]); w.z = cvt_pk_bf16(X[8 * sp + 4], X[8 * sp + 5]); w.w = cvt_pk_bf16(X[8 * sp + 6], X[8 * sp + 7]);
                pa[sp] = __builtin_bit_cast(bf16x8, w);
            }
            f32x16 oacc = f32x16{};
            oacc = __builtin_amdgcn_mfma_f32_32x32x16_bf16(pa[0], vb[0], oacc, 0, 0, 0);
            oacc = __builtin_amdgcn_mfma_f32_32x32x16_bf16(pa[1], vb[1], oacc, 0, 0, 0);
#pragma unroll
            for (int kt = 0; kt < 4; ++kt) {
#pragma unroll
                for (int sp = 0; sp < 2; ++sp) {
                    u32x4 w; w.x = cvt_pk_bf16(sacc[kt][8 * sp + 0], sacc[kt][8 * sp + 1]); w.y = cvt_pk_bf16(sacc[kt][8 * sp + 2], sacc[kt][8 * sp + 3]);
                    w.z = cvt_pk_bf16(sacc[kt][8 * sp + 4], sacc[kt][8 * sp + 5]); w.w = cvt_pk_bf16(sacc[kt][8 * sp + 6], sacc[kt][8 * sp + 7]);
                    const bf16x8 sb = __builtin_bit_cast(bf16x8, w);
                    const s16x4 lo = *(const s16x4*)(G + QT + r32 * 272 + (32 * kt + 16 * sp + 4 * hi) * 2);
                    const s16x4 h4 = *(const s16x4*)(G + QT + r32 * 272 + (32 * kt + 16 * sp + 8 + 4 * hi) * 2);
                    const bf16x8 qa = (bf16x8){lo[0], lo[1], lo[2], lo[3], h4[0], h4[1], h4[2], h4[3]};
                    oacc = __builtin_amdgcn_mfma_f32_32x32x16_bf16(qa, sb, oacc, 0, 0, 0);
                }
            }
#pragma unroll
            for (int kh = 0; kh < 2; ++kh) {
                s16x4 kf[2][2][2];
#pragma unroll
                for (int k2 = 0; k2 < 2; ++k2)
#pragma unroll
                    for (int sp = 0; sp < 2; ++sp)
#pragma unroll
                        for (int pp2 = 0; pp2 < 2; ++pp2) asm volatile("ds_read_b64_tr_b16 %0, %1 offset:%2" : "=&v"(kf[k2][sp][pp2]) : "v"(ktr), "i"(sp * 4352 + pp2 * 2176 + (2 * kh + k2) * 64) : "memory");
                asm volatile("s_waitcnt lgkmcnt(0)" : "+v"(kf[0][0][0]), "+v"(kf[0][0][1]), "+v"(kf[0][1][0]), "+v"(kf[0][1][1]), "+v"(kf[1][0][0]), "+v"(kf[1][0][1]), "+v"(kf[1][1][0]), "+v"(kf[1][1][1]) :: "memory");
#pragma unroll
                for (int k2 = 0; k2 < 2; ++k2) {
                    const int kt = 2 * kh + k2;
#pragma unroll
                    for (int sp = 0; sp < 2; ++sp) {
                        const bf16x8 ka = (bf16x8){kf[k2][sp][0][0], kf[k2][sp][0][1], kf[k2][sp][0][2], kf[k2][sp][0][3], kf[k2][sp][1][0], kf[k2][sp][1][1], kf[k2][sp][1][2], kf[k2][sp][1][3]};
                        sacc[kt] = __builtin_amdgcn_mfma_f32_32x32x16_bf16(ka, vb[sp], sacc[kt], 0, 0, 0);
                    }
#pragma unroll
                    for (int rq = 0; rq < 4; ++rq) { const f32x4 d4 = *(const f32x4*)(G + DL + (32 * kt + 8 * rq + 4 * hi) * 4);
                        sacc[kt][4 * rq + 0] *= d4[0]; sacc[kt][4 * rq + 1] *= d4[1]; sacc[kt][4 * rq + 2] *= d4[2]; sacc[kt][4 * rq + 3] *= d4[3]; }
                }
            }
#pragma unroll
            for (int r = 0; r < 16; ++r) ((float*)(G + OT))[crow(r, hi) * 128 + 32 * wv + r32] = oacc[r];
        }
        LDS_BAR();
    }
#undef HG_LOAD
#undef HG_LOADZ
}
}

__device__ __forceinline__ void transpose_w(const float* __restrict__ W, int K, int N, bf16_t* __restrict__ out, const float* __restrict__ ksc, bool permqk, float* tile  ) {
    const int tid = threadIdx.x, ntn = N / 64, ntk = K / 64, ntiles = ntn * ntk;
    const int lk = tid >> 3, lc = (tid & 7) * 8;
    for (int t = blockIdx.x; t < ntiles; t += gridDim.x) {
        const int n0 = (t % ntn) * 64, k0 = (t / ntn) * 64;
        const float sc = ksc ? ksc[k0 + lk] : 1.0f;
        float v[8];
#pragma unroll
        for (int j = 0; j < 8; ++j) {
            const int nv = n0 + lc + j; int nr = nv;
            if (permqk && nv < 1280) { const int cv = nv & 255; const int bj = cv >> 7, wc = (cv >> 5) & 3, fq = (cv >> 3) & 3, n = (cv >> 2) & 1, e = cv & 3; nr = (nv & ~255) + 64 * wc + 32 * bj + 16 * n + 4 * fq + e; }
            v[j] = W[(size_t)(k0 + lk) * N + nr] * ((permqk && nv >= 14 * 256 && nv < 22 * 256) ? sc * -1.4426950408889634f : sc);
        }
#pragma unroll
        for (int j = 0; j < 8; ++j) tile[(lc + j) * 65 + lk] = v[j];
        __syncthreads();
        const float* tr = tile + lk * 65 + lc;
        u32x4 w; w.x = cvt_pk_bf16(tr[0], tr[1]); w.y = cvt_pk_bf16(tr[2], tr[3]); w.z = cvt_pk_bf16(tr[4], tr[5]); w.w = cvt_pk_bf16(tr[6], tr[7]);
        *(u32x4*)(out + (size_t)(n0 + lk) * K + k0 + lc) = w;
        __syncthreads();
    }
}
__device__ __forceinline__ void rowprep(const float* __restrict__ x, bf16_t* __restrict__ xb, float* __restrict__ rrow, int gwave, int nwaves, int lane) {
    for (int row = gwave; row < NTOK; row += nwaves) {
        const float* xr = x + (size_t)row * DM; float ss = 0.f; f32x4 v[4];
#pragma unroll
        for (int i = 0; i < 4; ++i) { v[i] = *(const f32x4*)(xr + 4 * lane + 256 * i); const f32x4 q = v[i] * v[i]; ss += (q[0] + q[1]) + (q[2] + q[3]); }
#pragma unroll
        for (int o = 1; o < 64; o <<= 1) ss += __shfl_xor(ss, o);
        const float rn = 1.0f / sqrtf(ss * (1.0f / DM) + EPS);
#pragma unroll
        for (int i = 0; i < 4; ++i) { u32x2 w; w.x = cvt_pk_bf16(v[i][0] * rn, v[i][1] * rn); w.y = cvt_pk_bf16(v[i][2] * rn, v[i][3] * rn); *(u32x2*)(xb + (size_t)row * DM + 4 * lane + 256 * i) = w; }
    }
}
__device__ __forceinline__ void final_norm(float* __restrict__ x, const float* __restrict__ fw, int gwave, int nwaves, int lane) {
    for (int row = gwave; row < NTOK; row += nwaves) {
        float* xr = x + (size_t)row * DM; float ss = 0.f; f32x4 v[4];
#pragma unroll
        for (int i = 0; i < 4; ++i) { v[i] = *(const f32x4*)(xr + 4 * lane + 256 * i); const f32x4 q = v[i] * v[i]; ss += (q[0] + q[1]) + (q[2] + q[3]); }
#pragma unroll
        for (int o = 1; o < 64; o <<= 1) ss += __shfl_xor(ss, o);
        const float r = 1.0f / sqrtf(ss * (1.0f / DM) + EPS);
#pragma unroll
        for (int i = 0; i < 4; ++i) { const f32x4 w = *(const f32x4*)(fw + 4 * lane + 256 * i); __builtin_nontemporal_store(v[i] * r * w, (f32x4*)(xr + 4 * lane + 256 * i)); }
    }
}

#define XB_TMO      128
#define XB_XCNT(j)  (256  + 64 * (j))
#define XB_XSUB(j)  (1280 + 64 * (j))
#define XB_XGEN(j)  (2304 + 64 * (j))
#define XB_TOP      3328
#define XB_TOPGEN   3392
#define XCD_BAR_WORDS 3456
#define XB_SPIN_CAP (1u << 18)
__device__ __forceinline__ unsigned xb_ld(unsigned* p)              { return __hip_atomic_load(p, __ATOMIC_RELAXED, __HIP_MEMORY_SCOPE_AGENT); }
__device__ __forceinline__ unsigned xb_add(unsigned* p, unsigned v) { return __hip_atomic_fetch_add(p, v, __ATOMIC_RELAXED, __HIP_MEMORY_SCOPE_AGENT); }
__device__ __forceinline__ unsigned xb_xcc_id() { return (unsigned)__builtin_amdgcn_s_getreg((3 << 11) | 20) & 0xFu; }
#define XB_SPIN(cond, bar) do { unsigned _sp = 0; while (cond) { __builtin_amdgcn_s_sleep(1); \
    if ((++_sp & 255u) == 0u) { if (xb_ld(&(bar)[XB_TMO])) break; if (_sp > XB_SPIN_CAP) { atomicAdd(&(bar)[XB_TMO], 1u); break; } } } } while (0)
struct XcdBarrier { unsigned* bar; unsigned x; volatile LAS unsigned* st; };
__device__ __forceinline__ void xcd_barrier_post(unsigned* bar) { if (threadIdx.x == 0) (void)xb_add(&bar[XB_XCNT(xb_xcc_id())], 1u); }
__device__ __forceinline__ void xcd_barrier_complete(unsigned* bar, unsigned x, unsigned& nloc, unsigned& nx) {
    const unsigned G = gridDim.x * gridDim.y * gridDim.z;
    unsigned sum, cnt, mine, sp = 0u;
    for (;;) {
        sum = 0u; cnt = 0u; mine = 0u;
#pragma unroll
        for (unsigned j = 0; j < 16; ++j) { const unsigned c = xb_ld(&bar[XB_XCNT(j)]); sum += c; cnt += (c > 0u) ? 1u : 0u; mine = (j == x) ? c : mine; }
        if (sum == G) break;
        __builtin_amdgcn_s_sleep(1);
        if ((++sp & 255u) == 0u) { if (xb_ld(&bar[XB_TMO])) break; if (sp > XB_SPIN_CAP) { atomicAdd(&bar[XB_TMO], 1u); break; } }
    }
    nloc = mine > 0u ? mine : 1u; nx = cnt > 0u ? cnt : 1u;
}
__device__ __forceinline__ void xcd_barrier(const XcdBarrier& b) {
    asm volatile("s_waitcnt vmcnt(0)" ::: "memory");
    __syncthreads();
    if (threadIdx.x == 0) {
        unsigned* bar = b.bar;
        __builtin_amdgcn_s_waitcnt(0);
        unsigned nloc = b.st[0], nx = b.st[1];
        if (nloc == 0u) { xcd_barrier_complete(bar, b.x, nloc, nx); b.st[0] = nloc; b.st[1] = nx; }
        const unsigned old = xb_add(&bar[XB_XSUB(b.x)], 1u);
        const unsigned gen = old / nloc;
        if (old + 1u == (gen + 1u) * nloc) {
            __builtin_amdgcn_fence(__ATOMIC_RELEASE, "agent");
            asm volatile("s_waitcnt vmcnt(0)" ::: "memory");
            const unsigned og = xb_add(&bar[XB_TOP], 1u);
            const unsigned tg = og / nx;
            if (og + 1u == (tg + 1u) * nx) xb_add(&bar[XB_TOPGEN], 1u);
            else XB_SPIN(xb_ld(&bar[XB_TOPGEN]) == tg, bar);
            __builtin_amdgcn_fence(__ATOMIC_ACQUIRE, "agent");
            xb_add(&bar[XB_XGEN(b.x)], 1u);
            asm volatile("s_waitcnt vmcnt(0)" ::: "memory");
        } else {
            XB_SPIN(xb_ld(&bar[XB_XGEN(b.x)]) == gen, bar);
            __builtin_amdgcn_fence(__ATOMIC_ACQUIRE, "agent");
            asm volatile("s_waitcnt vmcnt(0)" ::: "memory");
        }
    }
    __syncthreads();
}

constexpr int ATT_LDS = 3 * att::SHM_V + 3 * att::SHM_K + 8 * 64 * 4;
constexpr int LDS_MAIN = (2 * hg::GROUP_BYTES > pg8::STAGE_BYTES ? 2 * hg::GROUP_BYTES : pg8::STAGE_BYTES);
constexpr int LDS_BYTES = LDS_MAIN + 16;
constexpr size_t WS_BAR = WS_END + 1024, WS_END2 = WS_BAR + XCD_BAR_WORDS * 4;
static_assert(ATT_LDS <= LDS_MAIN, "lds");
#ifndef PH_MASK
#define PH_MASK 31
#endif
#ifndef ATT_UA
#define ATT_UA 12
#endif
constexpr int UA = ATT_UA, UB = 16 - ATT_UA;

__global__ void __launch_bounds__(NTHREADS, 2) fwd_megakernel(Params p) {
    extern __shared__ __attribute__((aligned(16))) unsigned char lds[];
    cg::grid_group grid = cg::this_grid();
    typedef const __attribute__((address_space(4))) Params* KPtr;
    const int G = gridDim.x, c = blockIdx.x;
    volatile LAS unsigned* st = (volatile LAS unsigned*)((LAS unsigned char*)lds + LDS_MAIN);
    if (threadIdx.x < 2) st[threadIdx.x] = 0u;
    { const long gt0 = (long)blockIdx.x * NTHREADS + threadIdx.x; if (gt0 < XCD_BAR_WORDS) __hip_atomic_store((unsigned*)(((KPtr)__builtin_amdgcn_kernarg_segment_ptr())->ws + WS_BAR) + gt0, 0u, __ATOMIC_RELAXED, __HIP_MEMORY_SCOPE_AGENT); }
    __syncthreads();
#define GSYNC() do { XcdBarrier b_; b_.bar = (unsigned*)(KP()->ws + WS_BAR); b_.x = xb_xcc_id(); b_.st = st; xcd_barrier(b_); } while (0)
#define IDS() int tid_ = threadIdx.x; asm volatile("" : "+v"(tid_)); const int lane = tid_ & 63; const long gtid = (long)blockIdx.x * NTHREADS + tid_, gthreads = (long)gridDim.x * NTHREADS; const int gwave = (int)(gtid >> 6), nwaves = (int)(gthreads >> 6); (void)lane; (void)gwave; (void)nwaves;
#define KP() ({ const unsigned long long _a = (unsigned long long)__builtin_amdgcn_kernarg_segment_ptr(); unsigned _lo = __builtin_amdgcn_readfirstlane((unsigned)_a), _hi = __builtin_amdgcn_readfirstlane((unsigned)(_a >> 32)); asm volatile("" : "+s"(_lo), "+s"(_hi)); (KPtr)(((unsigned long long)_hi << 32) | _lo); })
#define WSP(kp, off) ((kp)->ws + (off))
#ifdef PROBE_DUR
#define STAMP(k) do { if ((blockIdx.x == 0 || blockIdx.x == 128) && threadIdx.x == 0) { const unsigned long long now_ = __builtin_amdgcn_s_memrealtime(); \
        unsigned long long* T_ = (unsigned long long*)(KP()->ws + WS_END) + (blockIdx.x ? 16 : 0); T_[k] += now_ - T_[15]; T_[15] = now_; } } while (0)
    if ((blockIdx.x == 0 || blockIdx.x == 128) && threadIdx.x == 0) { unsigned long long* T_ = (unsigned long long*)(KP()->ws + WS_END) + (blockIdx.x ? 16 : 0);
        for (int i_ = 0; i_ < 15; ++i_) T_[i_] = 0; T_[15] = __builtin_amdgcn_s_memrealtime(); }
#else
#define STAMP(k) do { } while (0)
#endif
    { IDS();
    for (int l = 0; l < DEPTH; ++l) {
        KPtr kp = KP();
        transpose_w(kp->w_in + (size_t)l * DM * NIN, DM, NIN, (bf16_t*)WSP(kp, WS_WIN) + (size_t)l * NIN * DM, kp->norm_w + l * DM, true, (float*)lds);
        transpose_w(kp->w_ba + (size_t)l * DM * DM, DM, DM, (bf16_t*)WSP(kp, WS_WA) + (size_t)l * DM * DM, nullptr, false, (float*)lds);
        transpose_w(kp->w_bh + (size_t)l * DM * DM, DM, DM, (bf16_t*)WSP(kp, WS_WH) + (size_t)l * DM * DM, nullptr, false, (float*)lds);
        transpose_w(kp->w_out + (size_t)l * DM * DM, DM, DM, (bf16_t*)WSP(kp, WS_WO) + (size_t)l * DM * DM, nullptr, false, (float*)lds);
    }
    { KPtr kp = KP(); float* TAB = (float*)WSP(kp, WS_TAB);
    if (gtid < 1536) {
        const int pos = (int)(gtid >> 4), i = (int)(gtid & 15);
        const float inv = powf(10000.0f, -(float)i / 16.0f);
        if (pos < 32) { const float a = (float)pos * inv; TAB[TAB_COSR + pos * 16 + i] = cosf(a); TAB[TAB_SINR + pos * 16 + i] = sinf(a); }
        else { const int pc = pos - 32; const float a = (float)pc * inv; TAB[TAB_COSC + pc * 16 + i] = cosf(a); TAB[TAB_SINC + pc * 16 + i] = sinf(a); }
    }
    if (gtid >= 4096 && gtid < 4096 + DEPTH) {
        const int l = (int)(gtid - 4096); float mq = 0.f, mk = 0.f;
        for (int i = 0; i < 64; ++i) { mq = fmaxf(mq, fabsf(kp->q_norm_w[l * 64 + i])); mk = fmaxf(mk, fabsf(kp->k_norm_w[l * 64 + i])); }
        TAB[TAB_M2 + l] = 0.18033688011112042f * 64.0f * mq * mk;
    }
    if (gtid >= 2048 && gtid < 2048 + 2048) {
        const int d = (int)((gtid - 2048) >> 10), k = (int)((gtid - 2048) & 1023);
        const float a0 = kp->lbnd[(size_t)(d * DEPTH + 0) * 1024 + k], a1 = kp->lbnd[(size_t)(d * DEPTH + 1) * 1024 + k];
        const float m = fmaxf(a0, a1), e0 = expf(a0 - m), e1 = expf(a1 - m);
        TAB[TAB_LB + (d * 2 + 0) * 1024 + k] = 0.0f; TAB[TAB_LB + (d * 2 + 1) * 1024 + k] = e1 / (e0 + e1);
    }
    rowprep(kp->x, (bf16_t*)WSP(kp, WS_XB), (float*)WSP(kp, WS_RROW), gwave, nwaves, lane); } }
    grid.sync(); xcd_barrier_post((unsigned*)(KP()->ws + WS_BAR)); STAMP(0);

    for (int layer = 0; layer < DEPTH; ++layer) {
        for (int half = 0; half < 2; ++half) {
            const size_t tok0 = (size_t)half * TH;
#if PH_MASK & 1
            {
                KPtr kp = KP();
                pg8::Gemm g{(const bf16_t*)WSP(kp, WS_XB) + tok0 * DM, (const bf16_t*)WSP(kp, WS_WIN) + (size_t)layer * NIN * DM, nullptr, nullptr, TH, NIN, DM};
                pg8::StaticOrder S; S.init(TH, NIN, G, c);
                EpiProj E{(bf16_t*)WSP(kp, WS_PROJ), (const float*)WSP(kp, WS_RROW) + tok0, (const float*)WSP(kp, WS_TAB), kp->q_norm_w + layer * 64, kp->k_norm_w + layer * 64, half ? 8 : 6};
                pg8::gemm_phase<EpiProj, pg8::StaticOrder>((LAS unsigned char*)lds, g, S, E);
            }
#endif
            GSYNC(); STAMP(1);
            {
                KPtr kp = KP();
                bf16_t* PROJ = (bf16_t*)WSP(kp, WS_PROJ); const float* TAB = (const float*)WSP(kp, WS_TAB);
                const int xcd = c & 7, j = c >> 3;
                const bool light = c < 128;
#if PH_MASK & 2
                if (light) hg::hgrn_item((char*)lds, PROJ, c >> 3, c & 7, TAB + TAB_LB + (0 * 2 + layer) * 1024, TAB + TAB_LB + (1 * 2 + layer) * 1024, kp->hnorm_w + layer * 128);
#endif
                __syncthreads(); STAMP(2);
                const int nun = light ? UB : UA, ubase = light ? 16 * UA + j : (j - 16);
#if PH_MASK & 4
                for (int i = 0; i < nun; ++i) {
                    const int u = ubase + 16 * i, grp = xcd * 8 + (u >> 5), w = u & 31;
                    const int bl = grp >> 2, kvh = grp & 3, head = kvh * 4 + (w & 3), qb = w >> 2;
                    const size_t r0 = (size_t)bl * SEQ;
                    att::attn_unit(PROJ + PO_Q + (r0 + qb * 256) * 1024 + head * 64, PROJ + PO_K + r0 * 256 + kvh * 64, PROJ + PO_V + r0 * 256 + kvh * 64,
                                   PROJ + PO_AG + (r0 + qb * 256) * 1024 + head * 64, TAB[TAB_M2 + layer], (char*)lds);
                }
#endif
                STAMP(3);
            }
            GSYNC(); STAMP(4);
#if PH_MASK & 8
            {
                KPtr kp = KP(); bf16_t* PROJ = (bf16_t*)WSP(kp, WS_PROJ);
                pg8::Gemm g{PROJ + PO_Q, (const bf16_t*)WSP(kp, WS_WA) + (size_t)layer * DM * DM, PROJ + PO_HQ, (const bf16_t*)WSP(kp, WS_WH) + (size_t)layer * DM * DM, TH, DM, DM};
                pg8::TwoPassOrder S; S.S.init(TH, DM, G, c);
                EpiMerge E{PROJ + (half ? PO_MA1 : PO_MA), PROJ + PO_MH};
                pg8::gemm_phase<EpiMerge, pg8::TwoPassOrder>((LAS unsigned char*)lds, g, S, E);
            }
#endif
            GSYNC(); STAMP(5);
#if PH_MASK & 16
            {
                KPtr kp = KP(); bf16_t* PROJ = (bf16_t*)WSP(kp, WS_PROJ);
                pg8::Gemm g{PROJ + (half ? PO_MA1 : PO_MA), (const bf16_t*)WSP(kp, WS_WO) + (size_t)layer * DM * DM, nullptr, nullptr, TH, DM, DM};
                pg8::StaticOrder S; S.init(TH, DM, G, c);
                EpiResid E{(layer == 0 ? kp->x : (const float*)kp->out) + tok0 * DM, kp->out + tok0 * DM};
                pg8::gemm_phase<EpiResid, pg8::StaticOrder>((LAS unsigned char*)lds, g, S, E);
            }
#endif
            if (half == 1) GSYNC();
            STAMP(6);
        }
        if (layer + 1 < DEPTH) { IDS(); KPtr kp = KP(); rowprep(kp->out, (bf16_t*)WSP(kp, WS_XB), (float*)WSP(kp, WS_RROW), gwave, nwaves, lane); GSYNC(); STAMP(7); }
    }
    { IDS(); KPtr kp = KP(); final_norm(kp->out, kp->fnorm_w, gwave, nwaves, lane); }
#ifdef PROBE_DUR
    GSYNC(); STAMP(8);
    if (blockIdx.x == 0) {
        const unsigned long long* T_ = (const unsigned long long*)(KP()->ws + WS_END);
        const unsigned long long dt = T_[PROBE_DUR], nn = T_[PROBE_RVR] / 100;
        float* o_ = KP()->out;
        for (unsigned long long i_ = threadIdx.x; i_ < nn; i_ += NTHREADS) o_[i_ * 64] += 0.1f;
        const unsigned long long t0_ = __builtin_amdgcn_s_memrealtime();
        while (__builtin_amdgcn_s_memrealtime() - t0_ < dt) __builtin_amdgcn_s_sleep(8);
    }
#endif
}

extern "C" void kernel_launch(void* const* d_in, const int* in_sizes, int n_in, void* d_out, int out_size, void* d_ws, size_t ws_size, hipStream_t stream) {
    static int grid_blocks = 0;
    if (grid_blocks == 0) {
        if (n_in != 11 || in_sizes[0] != NTOK * DM || out_size != NTOK * DM || ws_size < WS_END2) {
            fprintf(stderr, "kernel_launch: shape mismatch (n_in %d, in0 %d, out %d, ws %zu, need %zu)\n", n_in, n_in > 0 ? in_sizes[0] : -1, out_size, ws_size, (size_t)WS_END); grid_blocks = -1; return; }
        int dev = 0, cus = 0, per_cu = 0;
        hipGetDevice(&dev); hipDeviceGetAttribute(&cus, hipDeviceAttributeMultiprocessorCount, dev);
        if (hipFuncSetAttribute((const void*)fwd_megakernel, hipFuncAttributeMaxDynamicSharedMemorySize, LDS_BYTES) != hipSuccess) { fprintf(stderr, "kernel_launch: hipFuncSetAttribute failed\n"); grid_blocks = -1; return; }
        hipOccupancyMaxActiveBlocksPerMultiprocessor(&per_cu, (const void*)fwd_megakernel, NTHREADS, LDS_BYTES);
        if (per_cu < 1) { fprintf(stderr, "kernel_launch: occupancy query says %d\n", per_cu); per_cu = 1; }
        (void)hipGetLastError();
        grid_blocks = cus;
    }
    if (grid_blocks < 0) return;
    Params p{};
    p.x = (const float*)d_in[0]; p.w_in = (const float*)d_in[1]; p.norm_w = (const float*)d_in[2]; p.q_norm_w = (const float*)d_in[3]; p.k_norm_w = (const float*)d_in[4];
    p.lbnd = (const float*)d_in[5]; p.hnorm_w = (const float*)d_in[6]; p.w_ba = (const float*)d_in[7]; p.w_bh = (const float*)d_in[8]; p.w_out = (const float*)d_in[9];
    p.fnorm_w = (const float*)d_in[10]; p.out = (float*)d_out; p.ws = (unsigned char*)d_ws;
    void* args[] = {&p};
    hipError_t e = hipLaunchCooperativeKernel((const void*)fwd_megakernel, dim3(grid_blocks), dim3(NTHREADS), args, LDS_BYTES, stream);
    if (e != hipSuccess) fprintf(stderr, "cooperative launch failed: %s (grid %d)\n", hipGetErrorString(e), grid_blocks);
}
```

```cpp
#include <hip/hip_runtime.h>
#include <hip/hip_cooperative_groups.h>
#include <cstdio>
#include <cstdint>
namespace cg = cooperative_groups;

#define LAS __attribute__((address_space(3)))
typedef unsigned short bf16_t;
typedef short bf16x8 __attribute__((ext_vector_type(8)));
typedef short s16x4 __attribute__((ext_vector_type(4)));
typedef float f32x4 __attribute__((ext_vector_type(4)));
typedef float f32x16 __attribute__((ext_vector_type(16)));
typedef unsigned u32x4 __attribute__((ext_vector_type(4)));
typedef unsigned u32x2 __attribute__((ext_vector_type(2)));

constexpr int DM = 1024, SEQ = 2048, BATCH = 32, NTOK = BATCH * SEQ, NIN = 9728, DEPTH = 2;
constexpr int HB = 16, TH = HB * SEQ;
constexpr float EPS = 1e-6f;
constexpr int NTHREADS = 512;

constexpr size_t SZ_WIN = (size_t)NIN * DM * 2, SZ_W1 = (size_t)DM * DM * 2;
constexpr size_t WS_WIN = 0, WS_WA = WS_WIN + 2 * SZ_WIN, WS_WH = WS_WA + 2 * SZ_W1, WS_WO = WS_WH + 2 * SZ_W1;
constexpr size_t WS_XB = WS_WO + 2 * SZ_W1, WS_RROW = WS_XB + (size_t)NTOK * DM * 2, WS_TAB = WS_RROW + (size_t)NTOK * 4;
constexpr int TAB_COSR = 0, TAB_SINR = 512, TAB_COSC = 1024, TAB_SINC = 2048, TAB_LB = 3072, TAB_M2 = 3072 + 2 * 2 * 1024, TAB_FLOATS = TAB_M2 + 64;
constexpr size_t WS_PROJ = (WS_TAB + TAB_FLOATS * 4 + 255) / 256 * 256;
constexpr size_t PO_Q = 0, PO_K = (size_t)TH * 1024, PO_V = (size_t)TH * 1280, PO_AG = (size_t)TH * 1536, PO_HQ = PO_AG + (size_t)TH * 1024,
                 PO_ZF = PO_HQ + (size_t)TH * 1024, PO_ZB = PO_ZF + (size_t)TH * 1024, PO_HI = PO_ZB + (size_t)TH * 1024, PO_HG = PO_HI + (size_t)TH * 1024,
                 PO_MA = PO_HG + (size_t)TH * 1024, PO_MH = PO_MA + (size_t)TH * 1024, PO_MA1 = PO_MH + (size_t)TH * 1024, PO_END = PO_MA1 + (size_t)TH * 1024;
constexpr size_t WS_END = WS_PROJ + PO_END * 2;

struct Params {
    const float* x; const float* w_in; const float* norm_w; const float* q_norm_w; const float* k_norm_w; const float* lbnd; const float* hnorm_w;
    const float* w_ba; const float* w_bh; const float* w_out; const float* fnorm_w; float* out; unsigned char* ws;
};

typedef float f32x2_t __attribute__((ext_vector_type(2))); typedef __bf16 bf16x2_t __attribute__((ext_vector_type(2)));
__device__ __forceinline__ unsigned cvt_pk_bf16(float lo, float hi) { f32x2_t v = {lo, hi}; bf16x2_t b = __builtin_convertvector(v, bf16x2_t); return __builtin_bit_cast(unsigned, b); }
__device__ __forceinline__ unsigned cvt_pk_bf16_asm(float lo, float hi) { unsigned r; asm volatile("v_cvt_pk_bf16_f32 %0, %1, %2" : "=v"(r) : "v"(lo), "v"(hi)); return r; }
__device__ __forceinline__ float bf2f(unsigned short v) { return __uint_as_float((unsigned)v << 16); }
__device__ __forceinline__ float bflo(unsigned w) { return __uint_as_float(w << 16); }
__device__ __forceinline__ float bfhi(unsigned w) { return __uint_as_float(w & 0xffff0000u); }
__device__ __forceinline__ unsigned pack_h2(float a, float b) { _Float16 ha = (_Float16)a, hb = (_Float16)b; return (unsigned)__builtin_bit_cast(unsigned short, ha) | ((unsigned)__builtin_bit_cast(unsigned short, hb) << 16); }
__device__ __forceinline__ float h2f(unsigned short v) { return (float)__builtin_bit_cast(_Float16, v); }
__device__ __forceinline__ float sigmoidf_(float x) { return __builtin_amdgcn_rcpf(1.0f + __expf(-x)); }
__device__ __forceinline__ float siluf_(float x) { return x * __builtin_amdgcn_rcpf(1.0f + __expf(-x)); }
#define LDS_BAR() do { asm volatile("s_waitcnt lgkmcnt(0)" ::: "memory"); __builtin_amdgcn_s_barrier(); asm volatile("" ::: "memory"); } while (0)

#ifdef PROBE_DUR
#define GSTAMP(k) do { if (blockIdx.x == 0 && threadIdx.x == 0) { asm volatile("s_waitcnt vmcnt(0)" ::: "memory"); const unsigned long long now_ = __builtin_amdgcn_s_memrealtime(); \
        unsigned long long* T_ = (unsigned long long*)(((const __attribute__((address_space(4))) Params*)__builtin_amdgcn_kernarg_segment_ptr())->ws + WS_END); T_[k] += now_ - T_[15]; T_[15] = now_; } } while (0)
#else
#define GSTAMP(k) do { } while (0)
#endif
namespace pg8 {
constexpr int BM = 256, BK = 64, HALF = 128, HTB = HALF * BK * 2, STAGE_BYTES = 8 * HTB, NXCD = 8, WGM = 8;
__host__ __device__ __forceinline__ int lds_byte(int r, int c) { const int st = (r >> 4) * 2 + (c >> 5), rr = r & 15, cc = c & 31, ob = rr * 64 + cc * 2; return st * 1024 + (ob ^ (((ob >> 9) & 1) << 5)); }
__host__ __device__ __forceinline__ void stage_rc(int b, int& R, int& C) { const int st = b / 1024, sb = b % 1024, swz = sb ^ (((sb >> 9) & 1) << 5); R = (st >> 1) * 16 + swz / 64; C = (st & 1) * 32 + (swz % 64) / 2; }
__host__ __device__ __forceinline__ int perm32(int rho) { const int n = rho >> 4, i = rho & 15; return 8 * (i >> 2) + 4 * n + (i & 3); }

struct Unit { int pm, pn, z; };
struct Gemm { const bf16_t* A0; const bf16_t* B0; const bf16_t* A1; const bf16_t* B1; int M, N, K; };

struct StaticOrder {
    int nM, nN, nwg, G, c;
    __device__ void init(int M, int N, int G_, int c_) { nM = M / BM; nN = N / BM; nwg = nM * nN; G = G_; c = c_; }
    __device__ bool next(int i, Unit& u) const {
        const long L = (long)i * G + c; if (L >= nwg) return false;
        int wgid = (int)L; { const int q = nwg / NXCD, r = nwg % NXCD, xcd = wgid % NXCD, off = wgid / NXCD; wgid = (xcd < r ? xcd * (q + 1) : r * (q + 1) + (xcd - r) * q) + off; }
        const int nig = WGM * nN, gid = wgid / nig, fm = gid * WGM, gsz = (nM - fm) < WGM ? (nM - fm) : WGM;
        u.pm = fm + ((wgid % nig) % gsz); u.pn = (wgid % nig) / gsz; u.z = 0; return true;
    }
};
struct TwoPassOrder {
    StaticOrder S;
    __device__ bool next(int i, Unit& u) const { if (!S.next(i >> 1, u)) return false; u.z = i & 1; return true; }
};

template <class Epi, class Sched>
__device__ __forceinline__ void gemm_phase(LAS unsigned char* lds, const Gemm g, const Sched& S, const Epi& E) {
    int tid = threadIdx.x; asm volatile("" : "+v"(tid));
    const int wid = __builtin_amdgcn_readfirstlane(tid >> 6), lane = tid & 63, wr = wid >> 2, wc = wid & 3, fr = lane & 15, fq = lane >> 4;
    const int K = g.K, nt = K / BK;
    unsigned voffA[2], voffB[2];
#pragma unroll
    for (int i = 0; i < 2; ++i) { int R, C; stage_rc(tid * 16 + i * 8192, R, C); const int Rb = Epi::PERM ? ((R & ~31) + perm32(R & 31)) : R;
        voffA[i] = (unsigned)(R * K + C) * 2u; voffB[i] = (unsigned)(Rb * K + C) * 2u; }
    const size_t kstep = (size_t)(BK * 2);
    const size_t hstep = (size_t)HALF * K * 2;
    const size_t tstep = 2 * hstep;
    const unsigned ldsw = (unsigned)wid * 1024u;
    const int aoff = lds_byte(wr * 64 + fr, fq * 8), boff = lds_byte(wc * 32 + fr, fq * 8);
#define PG8_SA(b, h) (((b) * 2 + (h)) * HTB)
#define PG8_SB(b, h) ((4 + (b) * 2 + (h)) * HTB)
#define PG8_STAGE(bufoff, gbase, voff) do { _Pragma("unroll") for (int _i = 0; _i < 2; ++_i) \
        __builtin_amdgcn_global_load_lds((const unsigned*)((const char*)(gbase) + (voff)[_i]), (LAS unsigned*)(lds + (bufoff) + ldsw + _i * 8192), 16, 0, 0); } while (0)
#define PG8_LDA(dst, b, h) do { _Pragma("unroll") for (int m = 0; m < 4; ++m) _Pragma("unroll") for (int k = 0; k < 2; ++k) dst[m][k] = *(const LAS bf16x8*)(lds + PG8_SA(b, h) + aoff + m * 2048 + k * 1024); } while (0)
#define PG8_LDB(dst, b, h) do { _Pragma("unroll") for (int n = 0; n < 2; ++n) _Pragma("unroll") for (int k = 0; k < 2; ++k) dst[n][k] = *(const LAS bf16x8*)(lds + PG8_SB(b, h) + boff + n * 2048 + k * 1024); } while (0)
#define PG8_MMA(ai, bj, At, Bt) do { __builtin_amdgcn_s_setprio(1); _Pragma("unroll") for (int m = 0; m < 4; ++m) _Pragma("unroll") for (int n = 0; n < 2; ++n) _Pragma("unroll") for (int k = 0; k < 2; ++k) \
        acc[ai][bj][m][n] = __builtin_amdgcn_mfma_f32_16x16x32_bf16(Bt[n][k], At[m][k], acc[ai][bj][m][n], 0, 0, 0); __builtin_amdgcn_s_setprio(0); } while (0)
#define PG8_WAIT_V(n) asm volatile("s_waitcnt vmcnt(" #n ")" ::: "memory")
#define PG8_WAIT_L(n) asm volatile("s_waitcnt lgkmcnt(" #n ")" ::: "memory")
#define PG8_BAR __builtin_amdgcn_s_barrier()
#define PG8_SCHED __builtin_amdgcn_sched_barrier(0)
    Unit cur, nxt; int ui = 0;
    if (!S.next(0, cur)) return;
    f32x4 acc[2][2][4][2];
#pragma unroll
    for (int a = 0; a < 2; ++a)
#pragma unroll
        for (int b = 0; b < 2; ++b)
#pragma unroll
            for (int m = 0; m < 4; ++m)
#pragma unroll
                for (int n = 0; n < 2; ++n) acc[a][b][m][n] = (f32x4){0.f, 0.f, 0.f, 0.f};
    bf16x8 At[4][2], B0[2][2], B1[2][2];
    const char* cA = (const char*)(cur.z ? g.A1 : g.A0) + (size_t)cur.pm * tstep; const char* cB = (const char*)(cur.z ? g.B1 : g.B0) + (size_t)cur.pn * tstep;
    PG8_STAGE(PG8_SB(0, 0), cB, voffB); PG8_STAGE(PG8_SB(0, 1), cB + hstep, voffB); PG8_STAGE(PG8_SA(0, 0), cA, voffA); PG8_STAGE(PG8_SA(0, 1), cA + hstep, voffA);
    if (wr == 1) PG8_BAR;
    PG8_WAIT_V(2); PG8_BAR;
    PG8_STAGE(PG8_SB(1, 0), cB + kstep, voffB); PG8_STAGE(PG8_SA(1, 0), cA + kstep, voffA); PG8_STAGE(PG8_SB(1, 1), cB + hstep + kstep, voffB);
    PG8_WAIT_V(6); PG8_BAR;
    for (;;) {
        const bool has_next = S.next(ui + 1, nxt);
        const char* nA = has_next ? (const char*)(nxt.z ? g.A1 : g.A0) + (size_t)nxt.pm * tstep : cA; const char* nB = has_next ? (const char*)(nxt.z ? g.B1 : g.B0) + (size_t)nxt.pn * tstep : cB;
        for (int t = 0; t < nt; t += 2) {
            const bool last = (t == nt - 2);
            const char* a1 = cA + (size_t)(t + 1) * kstep;
            const char* a2 = last ? nA : cA + (size_t)(t + 2) * kstep; const char* b2 = last ? nB : cB + (size_t)(t + 2) * kstep;
            const char* a3 = a2 + kstep; const char* b3 = b2 + kstep;
            PG8_LDB(B0, 0, 0); PG8_LDB(B1, 0, 1); PG8_SCHED; PG8_LDA(At, 0, 0); PG8_STAGE(PG8_SA(1, 1), a1 + hstep, voffA);
            PG8_WAIT_V(8); PG8_WAIT_L(0); PG8_BAR; PG8_MMA(0, 0, At, B0); PG8_MMA(0, 1, At, B1); PG8_BAR; PG8_SCHED;
            PG8_LDA(At, 0, 1); PG8_STAGE(PG8_SB(0, 0), b2, voffB); PG8_STAGE(PG8_SB(0, 1), b2 + hstep, voffB); PG8_STAGE(PG8_SA(0, 0), a2, voffA);
            PG8_WAIT_V(8); PG8_WAIT_L(0); PG8_BAR; PG8_MMA(1, 0, At, B0); PG8_MMA(1, 1, At, B1); PG8_BAR; PG8_SCHED;
            PG8_LDB(B0, 1, 0); PG8_LDB(B1, 1, 1); PG8_SCHED; PG8_LDA(At, 1, 0); PG8_STAGE(PG8_SA(0, 1), a2 + hstep, voffA);
            PG8_WAIT_V(8); PG8_WAIT_L(0); PG8_BAR; PG8_MMA(0, 0, At, B0); PG8_MMA(0, 1, At, B1); PG8_BAR; PG8_SCHED;
            PG8_LDA(At, 1, 1); PG8_STAGE(PG8_SB(1, 0), b3, voffB); PG8_STAGE(PG8_SB(1, 1), b3 + hstep, voffB); PG8_STAGE(PG8_SA(1, 0), a3, voffA);
            PG8_WAIT_V(8); PG8_WAIT_L(0); PG8_BAR; PG8_MMA(1, 0, At, B0); PG8_MMA(1, 1, At, B1); PG8_BAR; PG8_SCHED;
        }
        if (wr == 0) PG8_BAR;
        GSTAMP(10);
        E(acc, cur, wr, wc, fr, fq);
        GSTAMP(11);
        if (!has_next) break;
        if (!(Epi::CARRY && cur.z == 0)) {
#pragma unroll
        for (int a = 0; a < 2; ++a)
#pragma unroll
            for (int b = 0; b < 2; ++b)
#pragma unroll
                for (int m = 0; m < 4; ++m)
#pragma unroll
                    for (int n = 0; n < 2; ++n) acc[a][b][m][n] = (f32x4){0.f, 0.f, 0.f, 0.f};
        }
        cur = nxt; cA = nA; cB = nB; ++ui;
        if (wr == 1) PG8_BAR;
    }
    PG8_WAIT_V(0);
    PG8_BAR;
#undef PG8_SA
#undef PG8_SB
#undef PG8_STAGE
#undef PG8_LDA
#undef PG8_LDB
#undef PG8_MMA
#undef PG8_WAIT_V
#undef PG8_WAIT_L
#undef PG8_BAR
#undef PG8_SCHED
}
}

struct EpiProj {
    static constexpr bool PERM = true, CARRY = false;
    bf16_t* proj; const float* rrow; const float* tab; const float* qw; const float* kw; int ma_sg;
    __device__ __forceinline__ void operator()(f32x4 (&acc)[2][2][4][2], const pg8::Unit& u, int wr, int wc, int fr, int fq) const {
        const int pn = u.pn;
        if (pn < 5) {
            const float* nw = (pn < 4) ? qw : kw;
            bf16_t* base = (pn < 4) ? (proj + PO_Q + pn * 256) : (proj + PO_K);
            const int ldc = (pn < 4) ? 1024 : 256;
#pragma unroll
            for (int ai = 0; ai < 2; ++ai)
#pragma unroll
                for (int m = 0; m < 4; ++m) {
                    const int row = u.pm * 256 + ai * 128 + wr * 64 + m * 16 + fr;
                    const int s = row & (SEQ - 1), prow = s >> 6, pcol = s & 63;
                    float ss = 0.f;
#pragma unroll
                    for (int bj = 0; bj < 2; ++bj)
#pragma unroll
                        for (int n = 0; n < 2; ++n) { const f32x4 q = acc[ai][bj][m][n] * acc[ai][bj][m][n]; ss += (q[0] + q[1]) + (q[2] + q[3]); }
                    ss += __shfl_xor(ss, 16); ss += __shfl_xor(ss, 32);
                    const float sc = ((pn < 4) ? 0.18033688011112042f : 1.0f) / sqrtf(ss * (1.0f / 64.0f) + EPS);
#pragma unroll
                    for (int bj = 0; bj < 2; ++bj) {
                        const f32x4 c = *(const f32x4*)(tab + (bj ? TAB_COSC + pcol * 16 : TAB_COSR + prow * 16) + 4 * fq);
                        const f32x4 sn = *(const f32x4*)(tab + (bj ? TAB_SINC + pcol * 16 : TAB_SINR + prow * 16) + 4 * fq);
                        const f32x4 w0 = *(const f32x4*)(nw + 32 * bj + 4 * fq), w1 = *(const f32x4*)(nw + 32 * bj + 16 + 4 * fq);
                        const f32x4 x1 = acc[ai][bj][m][0] * sc * w0, x2 = acc[ai][bj][m][1] * sc * w1;
                        const f32x4 o1 = x1 * c - x2 * sn, o2 = x2 * c + x1 * sn;
                        u32x4 w; w.x = cvt_pk_bf16(o1[0], o1[1]); w.y = cvt_pk_bf16(o1[2], o1[3]); w.z = cvt_pk_bf16(o2[0], o2[1]); w.w = cvt_pk_bf16(o2[2], o2[3]);
                        *(u32x4*)(base + (size_t)row * ldc + wc * 64 + bj * 32 + 8 * fq) = w;
                    }
                    if (m & 1) asm volatile("" ::: "memory");
                }
        } else {
            bf16_t* base; int ldc = 1024; bool f16 = false;
            if (pn == 5) { base = proj + PO_V; ldc = 256; }
            else { const int sg = (pn - 6) >> 2; base = proj + PO_AG + (size_t)(sg == 6 ? ma_sg : sg) * ((size_t)TH * 1024) + ((pn - 6) & 3) * 256; f16 = (sg == 2 || sg == 3); }
            const int col0 = wc * 32 + 8 * fq; const bool hq = (pn >= 10 && pn < 14), hgs = (pn >= 26 && pn < 30);
#pragma unroll
            for (int ai = 0; ai < 2; ++ai)
#pragma unroll
                for (int m = 0; m < 4; ++m) {
                    const int row = u.pm * 256 + ai * 128 + wr * 64 + m * 16 + fr;
                    bf16_t* rowp = base + (size_t)row * ldc + col0;
#pragma unroll
                    for (int bj = 0; bj < 2; ++bj) {
                        f32x4 v0 = acc[ai][bj][m][0], v1 = acc[ai][bj][m][1]; u32x4 w;
                        if (hq) {
#pragma unroll
                            for (int e = 0; e < 4; ++e) { v0[e] = siluf_(v0[e]) * 0.08838834764831845f; v1[e] = siluf_(v1[e]) * 0.08838834764831845f; } }
                        if (hgs) {
#pragma unroll
                            for (int e = 0; e < 4; ++e) { v0[e] = siluf_(v0[e]); v1[e] = siluf_(v1[e]); } }
                        if (f16) {
#pragma unroll
                            for (int e = 0; e < 4; ++e) { v0[e] = sigmoidf_(v0[e]); v1[e] = sigmoidf_(v1[e]); } }
                        if (f16) { w.x = pack_h2(v0[0], v0[1]); w.y = pack_h2(v0[2], v0[3]); w.z = pack_h2(v1[0], v1[1]); w.w = pack_h2(v1[2], v1[3]); }
                        else { w.x = cvt_pk_bf16(v0[0], v0[1]); w.y = cvt_pk_bf16(v0[2], v0[3]); w.z = cvt_pk_bf16(v1[0], v1[1]); w.w = cvt_pk_bf16(v1[2], v1[3]); }
                        *(u32x4*)(rowp + bj * 128) = w;
                    }
                }
        }
    }
};
struct EpiMerge {
    static constexpr bool PERM = true, CARRY = true;
    bf16_t* MA; const bf16_t* MH;
    __device__ __forceinline__ void operator()(f32x4 (&acc)[2][2][4][2], const pg8::Unit& u, int wr, int wc, int fr, int fq) const {
        const int col0 = u.pn * 256 + wc * 32 + 8 * fq;
#pragma unroll
        for (int ai = 0; ai < 2; ++ai)
#pragma unroll
            for (int m = 0; m < 4; ++m) {
                const int row = u.pm * 256 + ai * 128 + wr * 64 + m * 16 + fr;
#pragma unroll
                for (int bj = 0; bj < 2; ++bj) {
                    const size_t off = (size_t)row * 1024 + col0 + bj * 128;
                    const u32x4 g = *(const u32x4*)(MH + off);
                    const unsigned gw[4] = {g.x, g.y, g.z, g.w};
                    if (u.z == 0) {
                        const u32x4 a = *(const u32x4*)(MA + off);
                        const unsigned aw[4] = {a.x, a.y, a.z, a.w};
#pragma unroll
                        for (int q = 0; q < 4; ++q) {
                            const float r0 = (1.0f + __expf(-bflo(gw[q]))) * __builtin_amdgcn_rcpf(1.0f + __expf(-bflo(aw[q])));
                            const float r1 = (1.0f + __expf(-bfhi(gw[q]))) * __builtin_amdgcn_rcpf(1.0f + __expf(-bfhi(aw[q])));
                            acc[ai][bj][m][q >> 1][2 * (q & 1)] *= r0; acc[ai][bj][m][q >> 1][2 * (q & 1) + 1] *= r1;
                        }
                    } else {
                        float r[8];
#pragma unroll
                        for (int q = 0; q < 4; ++q) { r[2 * q] = sigmoidf_(bflo(gw[q])) * acc[ai][bj][m][q >> 1][2 * (q & 1)]; r[2 * q + 1] = sigmoidf_(bfhi(gw[q])) * acc[ai][bj][m][q >> 1][2 * (q & 1) + 1]; }
                        u32x4 w; w.x = cvt_pk_bf16(r[0], r[1]); w.y = cvt_pk_bf16(r[2], r[3]); w.z = cvt_pk_bf16(r[4], r[5]); w.w = cvt_pk_bf16(r[6], r[7]);
                        *(u32x4*)(MA + off) = w;
                    }
                }
                if (m == 3) asm volatile("" ::: "memory");
            }
    }
};
struct EpiResid {
    static constexpr bool PERM = false, CARRY = false;
    const float* xin; float* out;
    __device__ __forceinline__ void operator()(f32x4 (&acc)[2][2][4][2], const pg8::Unit& u, int wr, int wc, int fr, int fq) const {
        const int col0 = u.pn * 256 + wc * 32 + 4 * fq;
#pragma unroll
        for (int ai = 0; ai < 2; ++ai)
#pragma unroll
            for (int m = 0; m < 4; ++m) {
                const size_t off = (size_t)(u.pm * 256 + ai * 128 + wr * 64 + m * 16 + fr) * 1024 + col0;
#pragma unroll
                for (int bj = 0; bj < 2; ++bj)
#pragma unroll
                    for (int n = 0; n < 2; ++n) { const f32x4 b = *(const f32x4*)(xin + off + bj * 128 + n * 16); *(f32x4*)(out + off + bj * 128 + n * 16) = b + acc[ai][bj][m][n]; }
                if (m == 3) asm volatile("" ::: "memory");
            }
    }
};

namespace att {
constexpr int QBLK = 32, KVBLK = 64, LDQ = 1024, LDK = 256;
constexpr float SCALE = 0.125f, THR = 8.f;
constexpr int SHM_V = 8192, SHM_K = 8192;
__device__ __forceinline__ int crow(int r, int hi) { return (r & 3) + 8 * (r >> 2) + 4 * hi; }
#define SBAR() __builtin_amdgcn_sched_barrier(0)
__device__ __forceinline__ void partialSM(f32x16& p0) {
#pragma unroll
    for (int r = 0; r < 16; ++r) p0[r] = __builtin_amdgcn_exp2f(p0[r]);
}
__device__ __forceinline__ void finishSM(f32x16& p0, f32x16& p1, bf16x8& pa0, bf16x8& pa1, bf16x8& pa2, bf16x8& pa3) {
#pragma unroll
    for (int r = 0; r < 16; ++r) p1[r] = __builtin_amdgcn_exp2f(p1[r]);
#define PK4(P, BASE, OUT) do { unsigned a0 = cvt_pk_bf16(P[BASE + 0], P[BASE + 1]), a1 = cvt_pk_bf16(P[BASE + 2], P[BASE + 3]);   \
    unsigned b0 = cvt_pk_bf16(P[BASE + 4], P[BASE + 5]), b1 = cvt_pk_bf16(P[BASE + 6], P[BASE + 7]);                              \
    auto r0 = __builtin_amdgcn_permlane32_swap(a0, b0, false, false); auto r1 = __builtin_amdgcn_permlane32_swap(a1, b1, false, false); \
    u32x4 w = {r0[0], r1[0], r0[1], r1[1]}; OUT = *reinterpret_cast<bf16x8*>(&w); } while (0)
    PK4(p0, 0, pa0); PK4(p0, 8, pa1); PK4(p1, 0, pa2); PK4(p1, 8, pa3);
#undef PK4
}
__device__ __forceinline__ void qkt(f32x16& p0, f32x16& p1, const char* Ks, const bf16x8* qr, const f32x16& negm, int r32, int hi) {
    p0 = negm; p1 = negm;
#pragma unroll
    for (int d0 = 0; d0 < 4; ++d0) {
        const bf16x8 b0 = *reinterpret_cast<const bf16x8*>(Ks + (2 * d0 + hi) * 1024 + r32 * 16);
        const bf16x8 b1 = *reinterpret_cast<const bf16x8*>(Ks + (2 * d0 + hi) * 1024 + 512 + r32 * 16);
        p0 = __builtin_amdgcn_mfma_f32_32x32x16_bf16(b0, qr[d0], p0, 0, 0, 0);
        p1 = __builtin_amdgcn_mfma_f32_32x32x16_bf16(b1, qr[d0], p1, 0, 0, 0); }
}
__device__ __forceinline__ int v_st(int k, int c) { const int kk = (k & ~0xC) | ((k & 4) << 1) | ((k & 8) >> 1); return ((kk >> 3) * 2 + (c >> 5)) * 512 + ((kk & 7) * 32 + (c & 31)) * 2; }
__device__ __forceinline__ int v_rd_base(int lane) { return ((lane & 3) << 3) | (((lane >> 2) & 3) << 6) | (((lane >> 4) & 1) << 5) | (((lane >> 5) & 1) << 8); }
constexpr int v_rd_off(int d0, int ks, int half) { return d0 * 512 + ks * 2048 + half * 1024; }
template <int OFF> __device__ __forceinline__ s16x4 tr_read(int vb) { s16x4 r; asm volatile("ds_read_b64_tr_b16 %0, %1 offset:%2" : "=&v"(r) : "v"(vb), "i"(OFF) : "memory"); return r; }
template <int D0> __device__ __forceinline__ void pv_one(f32x16& od, int vb, bf16x8 pa0, bf16x8 pa1, bf16x8 pa2, bf16x8 pa3) {
    const s16x4 l0 = tr_read<v_rd_off(D0, 0, 0)>(vb), h0 = tr_read<v_rd_off(D0, 0, 1)>(vb), l1 = tr_read<v_rd_off(D0, 1, 0)>(vb), h1 = tr_read<v_rd_off(D0, 1, 1)>(vb);
    const s16x4 l2 = tr_read<v_rd_off(D0, 2, 0)>(vb), h2 = tr_read<v_rd_off(D0, 2, 1)>(vb), l3 = tr_read<v_rd_off(D0, 3, 0)>(vb), h3 = tr_read<v_rd_off(D0, 3, 1)>(vb);
    asm volatile("s_waitcnt lgkmcnt(0)" ::: "memory"); SBAR();
#define PK(L, H) (bf16x8){L[0], L[1], L[2], L[3], H[0], H[1], H[2], H[3]}
    od = __builtin_amdgcn_mfma_f32_32x32x16_bf16(pa0, PK(l0, h0), od, 0, 0, 0);
    od = __builtin_amdgcn_mfma_f32_32x32x16_bf16(pa1, PK(l1, h1), od, 0, 0, 0);
    od = __builtin_amdgcn_mfma_f32_32x32x16_bf16(pa2, PK(l2, h2), od, 0, 0, 0);
    od = __builtin_amdgcn_mfma_f32_32x32x16_bf16(pa3, PK(l3, h3), od, 0, 0, 0);
#undef PK
}
__device__ __forceinline__ void pv_d0(f32x16* o, f32x16& lacc, int vb, bf16x8 pa0, bf16x8 pa1, bf16x8 pa2, bf16x8 pa3) {
    const bf16x8 ones = (bf16x8){0x3F80, 0x3F80, 0x3F80, 0x3F80, 0x3F80, 0x3F80, 0x3F80, 0x3F80};
    pv_one<0>(o[0], vb, pa0, pa1, pa2, pa3);
    lacc = __builtin_amdgcn_mfma_f32_32x32x16_bf16(pa0, ones, lacc, 0, 0, 0);
    lacc = __builtin_amdgcn_mfma_f32_32x32x16_bf16(pa1, ones, lacc, 0, 0, 0);
    pv_one<1>(o[1], vb, pa0, pa1, pa2, pa3);
    lacc = __builtin_amdgcn_mfma_f32_32x32x16_bf16(pa2, ones, lacc, 0, 0, 0);
    lacc = __builtin_amdgcn_mfma_f32_32x32x16_bf16(pa3, ones, lacc, 0, 0, 0);
}

__device__ __forceinline__ void attn_unit(bf16_t* Qb, const bf16_t* __restrict__ Kh, const bf16_t* __restrict__ Vh, const bf16_t* __restrict__ Gb, float m2, char* lds) {
    int tid = threadIdx.x; asm volatile("" : "+v"(tid));
    const int wid = tid >> 6, lane = tid & 63, r32 = lane & 31, hi = lane >> 5;
    char* V_lds = lds; char* K_lds = lds + 3 * SHM_V;
    float* ws = (float*)(lds + 3 * SHM_V + 3 * SHM_K) + wid * 64; float* li_l = ws;
    f32x16 lacc = {}; f32x16 o[2] = {}; bf16x8 qr[4];
    f32x16 negm;
#pragma unroll
    for (int r = 0; r < 16; ++r) negm[r] = -m2;
    const bf16_t* Qw = Qb + (size_t)(wid * QBLK + r32) * LDQ + hi * 8;
#pragma unroll
    for (int d0 = 0; d0 < 4; ++d0) qr[d0] = *reinterpret_cast<const bf16x8*>(Qw + d0 * 16);
    const int krow = tid & 63, kch = tid >> 6, kst = kch * 1024 + krow * 16;
    const int sr = tid >> 3, sc = (tid & 7) * 8, vst0 = v_st(sr, sc);
    const int vb0 = (int)(uintptr_t)V_lds + v_rd_base(lane);
    bf16x8 svA, skA, svB, skB;
#define SLOADA(k0) do { svA = *reinterpret_cast<const bf16x8*>(&Vh[(size_t)((k0) + sr) * LDK + sc]); skA = *reinterpret_cast<const bf16x8*>(&Kh[(size_t)((k0) + krow) * LDK + kch * 8]); } while (0)
#define SLOADB(k0) do { svB = *reinterpret_cast<const bf16x8*>(&Vh[(size_t)((k0) + sr) * LDK + sc]); skB = *reinterpret_cast<const bf16x8*>(&Kh[(size_t)((k0) + krow) * LDK + kch * 8]); } while (0)
#define SWRITEA(bo) do { *(bf16x8*)(V_lds + (bo) + vst0) = svA; *(bf16x8*)(K_lds + (bo) + kst) = skA; } while (0)
#define SWRITEB(bo) do { *(bf16x8*)(V_lds + (bo) + vst0) = svB; *(bf16x8*)(K_lds + (bo) + kst) = skB; } while (0)
    f32x16 pA0, pA1, pB0, pB1; bf16x8 pa0, pa1, pa2, pa3; constexpr int NT = SEQ / KVBLK;
    static_assert(SHM_V == SHM_K, "one rotating offset serves both rings");
    SLOADA(0); SLOADB(KVBLK); asm volatile("s_waitcnt vmcnt(2)" ::: "memory"); SWRITEA(0); SLOADA(2 * KVBLK); __syncthreads();
    SWRITEB(SHM_V); SLOADB(3 * KVBLK);
    qkt(pA0, pA1, K_lds, qr, negm, r32, hi); partialSM(pA0);
    __syncthreads();
    int bp = 0, bc = SHM_V, bn = 2 * SHM_V;
#define ROT3() do { const int t_ = bp; bp = bc; bc = bn; bn = t_; } while (0)
#define STEP_ODD(j) do { \
        SBAR(); qkt(pB0, pB1, K_lds + bc, qr, negm, r32, hi); \
        finishSM(pA0, pA1, pa0, pa1, pa2, pa3); SBAR(); \
        if ((j) + 1 < NT) SWRITEA(bn); \
        if ((j) + 3 < NT) SLOADA(((j) + 3) * KVBLK); SBAR(); \
        pv_d0(o, lacc, vb0 + bp, pa0, pa1, pa2, pa3); partialSM(pB0); \
        __syncthreads(); ROT3(); } while (0)
#define STEP_EVEN(j) do { \
        SBAR(); qkt(pA0, pA1, K_lds + bc, qr, negm, r32, hi); \
        finishSM(pB0, pB1, pa0, pa1, pa2, pa3); SBAR(); \
        if ((j) + 1 < NT) SWRITEB(bn); \
        if ((j) + 3 < NT) SLOADB(((j) + 3) * KVBLK); SBAR(); \
        pv_d0(o, lacc, vb0 + bp, pa0, pa1, pa2, pa3); partialSM(pA0); \
        __syncthreads(); ROT3(); } while (0)
    for (int j = 1; j + 1 < NT; j += 2) { STEP_ODD(j); STEP_EVEN(j + 1); }
    STEP_ODD(NT - 1);
    finishSM(pB0, pB1, pa0, pa1, pa2, pa3); SBAR();
    pv_d0(o, lacc, vb0 + bp, pa0, pa1, pa2, pa3);
#undef STEP_ODD
#undef STEP_EVEN
#undef ROT3
    float rli[16];
#pragma unroll
    for (int r = 0; r < 16; ++r) rli[r] = __builtin_amdgcn_rcpf(lacc[r]);
    __syncthreads();
    bf16_t* stg = (bf16_t*)lds + wid * 2048;
#pragma unroll
    for (int r = 0; r < 16; ++r) { const int orow = crow(r, hi);
#pragma unroll
        for (int d0 = 0; d0 < 2; ++d0) stg[orow * 64 + d0 * 32 + r32] = (bf16_t)(cvt_pk_bf16(o[d0][r] * rli[r], 0.f) & 0xffffu); }
    asm volatile("s_waitcnt lgkmcnt(0)" ::: "memory");
#pragma unroll
    for (int i = 0; i < 4; ++i) {
        const int row = i * 8 + (lane >> 3), ch = lane & 7;
        const u32x4 v = *(const u32x4*)(stg + row * 64 + ch * 8);
        const size_t goff = (size_t)(wid * QBLK + row) * LDQ + ch * 8;
        const u32x4 g = *(const u32x4*)(Gb + goff);
        u32x4 w;
        w.x = cvt_pk_bf16(bflo(v.x) * siluf_(bflo(g.x)), bfhi(v.x) * siluf_(bfhi(g.x))); w.y = cvt_pk_bf16(bflo(v.y) * siluf_(bflo(g.y)), bfhi(v.y) * siluf_(bfhi(g.y)));
        w.z = cvt_pk_bf16(bflo(v.z) * siluf_(bflo(g.z)), bfhi(v.z) * siluf_(bfhi(g.z))); w.w = cvt_pk_bf16(bflo(v.w) * siluf_(bflo(g.w)), bfhi(v.w) * siluf_(bfhi(g.w)));
        *(u32x4*)(Qb + goff) = w;
    }
    __syncthreads();
#undef SLOADA
#undef SLOADB
#undef SWRITEA
#undef SWRITEB
#undef SWAIT
}
}

namespace hg {
constexpr int QRAW = 0, ZRAW = 8192, VRAW = 16384, QT = 24576, KT = QT + 8704, KDT = KT + 8704, DL = KDT + 10240, TOT = DL + 512, OT = TOT + 1024, GROUP_BYTES = OT + 16384;
constexpr int NC = SEQ / 32;
__device__ __forceinline__ int crow(int r, int hi) { return (r & 3) + 8 * (r >> 2) + 4 * hi; }
__device__ __forceinline__ void hgrn_item(char* lds, bf16_t* proj, int bl, int h, const float* lb0, const float* lb1, const float* gw) {
    int tid = threadIdx.x; asm volatile("" : "+v"(tid));
    const int gd = __builtin_amdgcn_readfirstlane(tid >> 8), wv = __builtin_amdgcn_readfirstlane((tid >> 6) & 3);
    const int gt = tid & 255, lane = tid & 63, r32 = lane & 31, hi = lane >> 5;
    char* G = lds + gd * GROUP_BYTES;
    const size_t hb = (size_t)bl * SEQ * 1024 + h * 128;
    bf16_t* HQp = proj + PO_HQ + hb;
    const bf16_t* Zp = proj + (gd ? PO_ZB : PO_ZF) + hb;
    bf16_t* PW = proj + (gd ? PO_ZB : PO_ZF) + hb;
    const bf16_t* PR = proj + (gd ? PO_ZF : PO_ZB) + hb;
    const bf16_t* HIp = proj + PO_HI + hb; const bf16_t* HGp = proj + PO_HG + hb;
    const int k0 = 2 * lane, tg = wv;
    const float lbA = (gd ? lb1 : lb0)[h * 128 + k0], lbB = (gd ? lb1 : lb0)[h * 128 + k0 + 1], omA = 1.0f - lbA, omB = 1.0f - lbB;
    f32x16 sacc[4];
#pragma unroll
    for (int i = 0; i < 4; ++i) sacc[i] = f32x16{};
    unsigned zr[8], qq8[8]; u32x4 pv[2];
    const int prow0 = gt >> 4, pc8 = (gt & 15) * 8;
    const int rfirst = gd ? 31 - 8 * tg : 8 * tg, rstep = gd ? -1 : 1;
#define HG_LOADZ(dst, c) do { _Pragma("unroll") for (int j = 0; j < 8; ++j) dst[j] = *(const unsigned*)(Zp + (size_t)((c) * 32 + rfirst + j * rstep) * 1024 + k0); } while (0)
#define HG_LOAD(dq, dv, c) do { _Pragma("unroll") for (int j = 0; j < 8; ++j) { const size_t go = (size_t)((c) * 32 + rfirst + j * rstep) * 1024 + k0; \
        dq[j] = *(const unsigned*)(HQp + go); } \
        _Pragma("unroll") for (int ii = 0; ii < 2; ++ii) dv[ii] = *(const u32x4*)(HIp + (size_t)((c) * 32 + prow0 + 16 * ii) * 1024 + pc8); } while (0)
    HG_LOADZ(zr, gd ? NC - 1 : 0); HG_LOAD(qq8, pv, gd ? NC - 1 : 0);
    const int i16 = r32 & 15, g16 = r32 >> 4;
    const int vtr = (int)(uintptr_t)(G + VRAW) + (gd ? (7 - 4 * hi - (i16 >> 2)) : (4 * hi + (i16 >> 2))) * 256 + (32 * wv + 16 * g16 + 4 * (i16 & 3)) * 2;
    const int ktr = (int)(uintptr_t)(G + KT) + (4 * hi + (i16 >> 2)) * 272 + (16 * g16 + 4 * (i16 & 3)) * 2;
    const int et = gt >> 3, ec16 = (gt & 7) * 16;
    float gwr[16];
#pragma unroll
    for (int j = 0; j < 16; ++j) gwr[j] = gw[ec16 + j];
    size_t ego = 0; unsigned long long pw[4] = {0, 0, 0, 0}; u32x4 g0 = {0, 0, 0, 0}, g1 = {0, 0, 0, 0};
    float feA[8], feB[8], PlA[8], PlB[8];
    f32x16 mk;
#pragma unroll
    for (int r = 0; r < 16; ++r) mk[r] = (crow(r, hi) <= r32) ? 1.0f : 0.0f;
    for (int i = 0; i <= NC; ++i) {
        if (i > 0) {
            float ov[16];
#pragma unroll
            for (int q4 = 0; q4 < 4; ++q4) { const f32x4 v = *(const f32x4*)(G + OT + (et * 128 + ec16 + 4 * q4) * 4); ov[4 * q4] = v[0]; ov[4 * q4 + 1] = v[1]; ov[4 * q4 + 2] = v[2]; ov[4 * q4 + 3] = v[3]; }
            if (i - 1 < NC / 2) {
                u32x4 w0, w1;
                w0.x = cvt_pk_bf16(ov[0], ov[1]); w0.y = cvt_pk_bf16(ov[2], ov[3]); w0.z = cvt_pk_bf16(ov[4], ov[5]); w0.w = cvt_pk_bf16(ov[6], ov[7]);
                w1.x = cvt_pk_bf16(ov[8], ov[9]); w1.y = cvt_pk_bf16(ov[10], ov[11]); w1.z = cvt_pk_bf16(ov[12], ov[13]); w1.w = cvt_pk_bf16(ov[14], ov[15]);
                *(u32x4*)(PW + ego) = w0; *(u32x4*)(PW + ego + 8) = w1;
                if (i == NC / 2) asm volatile("s_waitcnt vmcnt(0)" ::: "memory");
            } else {
                float ss = 0.f;
#pragma unroll
                for (int q4 = 0; q4 < 4; ++q4) { const unsigned lo = (unsigned)pw[q4], hi2 = (unsigned)(pw[q4] >> 32);
                    ov[4 * q4] += bflo(lo); ov[4 * q4 + 1] += bfhi(lo); ov[4 * q4 + 2] += bflo(hi2); ov[4 * q4 + 3] += bfhi(hi2); }
#pragma unroll
                for (int j = 0; j < 16; ++j) ss += ov[j] * ov[j];
                ss += __shfl_xor(ss, 1); ss += __shfl_xor(ss, 2); ss += __shfl_xor(ss, 4);
                const float rstd = __builtin_amdgcn_rsqf(ss * (1.0f / 128.0f) + EPS);
                const unsigned gg[8] = {g0.x, g0.y, g0.z, g0.w, g1.x, g1.y, g1.z, g1.w};
                unsigned wo[8];
#pragma unroll
                for (int j = 0; j < 8; ++j) { const float a = ov[2 * j] * rstd * gwr[2 * j] * bflo(gg[j]), b = ov[2 * j + 1] * rstd * gwr[2 * j + 1] * bfhi(gg[j]); wo[j] = cvt_pk_bf16(a, b); }
                *(u32x4*)(HQp + ego) = (u32x4){wo[0], wo[1], wo[2], wo[3]}; *(u32x4*)(HQp + ego + 8) = (u32x4){wo[4], wo[5], wo[6], wo[7]};
            }
        }
        if (i == NC) break;
        const int c = gd ? NC - 1 - i : i;
        {
            float PA = 1.0f, PB = 1.0f;
#pragma unroll
            for (int j = 0; j < 8; ++j) {
                const float sA = h2f((unsigned short)(zr[j] & 0xffffu)), sB = h2f((unsigned short)(zr[j] >> 16));
                PA *= lbA + omA * sA; PB *= lbB + omB * sB; PlA[j] = PA; PlB[j] = PB; feA[j] = omA - omA * sA; feB[j] = omB - omB * sB; }
            *(float2*)(G + TOT + (tg * 128 + k0) * 4) = make_float2(PA, PB);
            if (i + 1 < NC) { const int c1 = gd ? c - 1 : c + 1; HG_LOADZ(zr, c1); }
        }
        LDS_BAR();
        {
            float preA = 1.0f, preB = 1.0f, plA = 1.0f, plB = 1.0f;
#pragma unroll
            for (int g4 = 0; g4 < 4; ++g4) { const float2 tt = *(const float2*)(G + TOT + (g4 * 128 + k0) * 4); plA *= tt.x; plB *= tt.y; if (g4 < tg) { preA *= tt.x; preB *= tt.y; } }
#pragma unroll
            for (int j = 0; j < 8; ++j) { const int t = 8 * tg + j;
                const float PtA = preA * PlA[j], PtB = preB * PlB[j];
                const float ktA = feA[j] * __builtin_amdgcn_rcpf(fmaxf(PtA, 1e-30f)), ktB = feB[j] * __builtin_amdgcn_rcpf(fmaxf(PtB, 1e-30f));
                *(unsigned*)(G + QT + t * 272 + k0 * 2) = cvt_pk_bf16(bflo(qq8[j]) * PtA, bfhi(qq8[j]) * PtB);
                *(unsigned*)(G + KT + t * 272 + k0 * 2) = cvt_pk_bf16(ktA, ktB);
            }
            if (tg == 0) *(float2*)(G + DL + k0 * 4) = make_float2(plA, plB);
#pragma unroll
            for (int ii = 0; ii < 2; ++ii) *(u32x4*)(G + VRAW + (prow0 + 16 * ii) * 256 + pc8 * 2) = pv[ii];
            ego = (size_t)(c * 32 + (gd ? 31 - et : et)) * 1024 + ec16;
            if (i >= NC / 2) {
                const unsigned long long* pp = (const unsigned long long*)(PR + ego);
#pragma unroll
                for (int q4 = 0; q4 < 4; ++q4) pw[q4] = __hip_atomic_load(pp + q4, __ATOMIC_RELAXED, __HIP_MEMORY_SCOPE_AGENT);
                g0 = *(const u32x4*)(HGp + ego); g1 = *(const u32x4*)(HGp + ego + 8);
            }
            if (i + 1 < NC) { const int c1 = gd ? c - 1 : c + 1; HG_LOAD(qq8, pv, c1); }
        }
        LDS_BAR();
        {
            s16x4 v00, v01, v10, v11;
            if (gd == 0) {
                asm volatile("ds_read_b64_tr_b16 %0, %1 offset:0" : "=&v"(v00) : "v"(vtr) : "memory"); asm volatile("ds_read_b64_tr_b16 %0, %1 offset:2048" : "=&v"(v01) : "v"(vtr) : "memory");
                asm volatile("ds_read_b64_tr_b16 %0, %1 offset:4096" : "=&v"(v10) : "v"(vtr) : "memory"); asm volatile("ds_read_b64_tr_b16 %0, %1 offset:6144" : "=&v"(v11) : "v"(vtr) : "memory");
            } else {
                asm volatile("ds_read_b64_tr_b16 %0, %1 offset:6144" : "=&v"(v00) : "v"(vtr) : "memory"); asm volatile("ds_read_b64_tr_b16 %0, %1 offset:4096" : "=&v"(v01) : "v"(vtr) : "memory");
                asm volatile("ds_read_b64_tr_b16 %0, %1 offset:2048" : "=&v"(v10) : "v"(vtr) : "memory"); asm volatile("ds_read_b64_tr_b16 %0, %1 offset:0" : "=&v"(v11) : "v"(vtr) : "memory");
            }
            f32x16 X = f32x16{};
#pragma unroll
            for (int ks = 0; ks < 8; ++ks) {
                const bf16x8 a = *(const bf16x8*)(G + KT + r32 * 272 + (16 * ks + 8 * hi) * 2);
                const bf16x8 b = *(const bf16x8*)(G + QT + r32 * 272 + (16 * ks + 8 * hi) * 2);
                X = __builtin_amdgcn_mfma_f32_32x32x16_bf16(a, b, X, 0, 0, 0);
            }
            X = X * mk;
            asm volatile("s_waitcnt lgkmcnt(0)" : "+v"(v00), "+v"(v01), "+v"(v10), "+v"(v11) :: "memory");
            bf16x8 pa[2], vb[2];
            vb[0] = (bf16x8){v00[0], v00[1], v00[2], v00[3], v01[0], v01[1], v01[2], v01[3]};
            vb[1] = (bf16x8){v10[0], v10[1], v10[2], v10[3], v11[0], v11[1], v11[2], v11[3]};
#pragma unroll
            for (int sp = 0; sp < 2; ++sp) {
                u32x4 w; w.x = cvt_pk_bf16(X[8 * sp + 0], X[8 * sp + 1]); w.y = cvt_pk_bf16(X[8 * sp + 2], X[8 * sp + 3]); w.z = cvt_pk_bf16(X[8 * sp + 4], X[8 * sp + 5]); w.w = cvt_pk_bf16(X[8 * sp + 6], X[8 * sp + 7]);
                pa[sp] = __builtin_bit_cast(bf16x8, w);
            }
            f32x16 oacc = f32x16{};
            oacc = __builtin_amdgcn_mfma_f32_32x32x16_bf16(pa[0], vb[0], oacc, 0, 0, 0);
            oacc = __builtin_amdgcn_mfma_f32_32x32x16_bf16(pa[1], vb[1], oacc, 0, 0, 0);
#pragma unroll
            for (int kt = 0; kt < 4; ++kt) {
#pragma unroll
                for (int sp = 0; sp < 2; ++sp) {
                    u32x4 w; w.x = cvt_pk_bf16(sacc[kt][8 * sp + 0], sacc[kt][8 * sp + 1]); w.y = cvt_pk_bf16(sacc[kt][8 * sp + 2], sacc[kt][8 * sp + 3]);
                    w.z = cvt_pk_bf16(sacc[kt][8 * sp + 4], sacc[kt][8 * sp + 5]); w.w = cvt_pk_bf16(sacc[kt][8 * sp + 6], sacc[kt][8 * sp + 7]);
                    const bf16x8 sb = __builtin_bit_cast(bf16x8, w);
                    const s16x4 lo = *(const s16x4*)(G + QT + r32 * 272 + (32 * kt + 16 * sp + 4 * hi) * 2);
                    const s16x4 h4 = *(const s16x4*)(G + QT + r32 * 272 + (32 * kt + 16 * sp + 8 + 4 * hi) * 2);
                    const bf16x8 qa = (bf16x8){lo[0], lo[1], lo[2], lo[3], h4[0], h4[1], h4[2], h4[3]};
                    oacc = __builtin_amdgcn_mfma_f32_32x32x16_bf16(qa, sb, oacc, 0, 0, 0);
                }
            }
#pragma unroll
            for (int kh = 0; kh < 2; ++kh) {
                s16x4 kf[2][2][2];
#pragma unroll
                for (int k2 = 0; k2 < 2; ++k2)
#pragma unroll
                    for (int sp = 0; sp < 2; ++sp)
#pragma unroll
                        for (int pp2 = 0; pp2 < 2; ++pp2) asm volatile("ds_read_b64_tr_b16 %0, %1 offset:%2" : "=&v"(kf[k2][sp][pp2]) : "v"(ktr), "i"(sp * 4352 + pp2 * 2176 + (2 * kh + k2) * 64) : "memory");
                asm volatile("s_waitcnt lgkmcnt(0)" : "+v"(kf[0][0][0]), "+v"(kf[0][0][1]), "+v"(kf[0][1][0]), "+v"(kf[0][1][1]), "+v"(kf[1][0][0]), "+v"(kf[1][0][1]), "+v"(kf[1][1][0]), "+v"(kf[1][1][1]) :: "memory");
#pragma unroll
                for (int k2 = 0; k2 < 2; ++k2) {
                    const int kt = 2 * kh + k2;
#pragma unroll
                    for (int sp = 0; sp < 2; ++sp) {
                        const bf16x8 ka = (bf16x8){kf[k2][sp][0][0], kf[k2][sp][0][1], kf[k2][sp][0][2], kf[k2][sp][0][3], kf[k2][sp][1][0], kf[k2][sp][1][1], kf[k2][sp][1][2], kf[k2][sp][1][3]};
                        sacc[kt] = __builtin_amdgcn_mfma_f32_32x32x16_bf16(ka, vb[sp], sacc[kt], 0, 0, 0);
                    }
#pragma unroll
                    for (int rq = 0; rq < 4; ++rq) { const f32x4 d4 = *(const f32x4*)(G + DL + (32 * kt + 8 * rq + 4 * hi) * 4);
                        sacc[kt][4 * rq + 0] *= d4[0]; sacc[kt][4 * rq + 1] *= d4[1]; sacc[kt][4 * rq + 2] *= d4[2]; sacc[kt][4 * rq + 3] *= d4[3]; }
                }
            }
#pragma unroll
            for (int r = 0; r < 16; ++r) ((float*)(G + OT))[crow(r, hi) * 128 + 32 * wv + r32] = oacc[r];
        }
        LDS_BAR();
    }
#undef HG_LOAD
#undef HG_LOADZ
}
}

__device__ __forceinline__ void transpose_w(const float* __restrict__ W, int K, int N, bf16_t* __restrict__ out, const float* __restrict__ ksc, bool permqk, float* tile  ) {
    const int tid = threadIdx.x, ntn = N / 64, ntk = K / 64, ntiles = ntn * ntk;
    const int lk = tid >> 3, lc = (tid & 7) * 8;
    for (int t = blockIdx.x; t < ntiles; t += gridDim.x) {
        const int n0 = (t % ntn) * 64, k0 = (t / ntn) * 64;
        const float sc = ksc ? ksc[k0 + lk] : 1.0f;
        float v[8];
#pragma unroll
        for (int j = 0; j < 8; ++j) {
            const int nv = n0 + lc + j; int nr = nv;
            if (permqk && nv < 1280) { const int cv = nv & 255; const int bj = cv >> 7, wc = (cv >> 5) & 3, fq = (cv >> 3) & 3, n = (cv >> 2) & 1, e = cv & 3; nr = (nv & ~255) + 64 * wc + 32 * bj + 16 * n + 4 * fq + e; }
            v[j] = W[(size_t)(k0 + lk) * N + nr] * sc;
        }
#pragma unroll
        for (int j = 0; j < 8; ++j) tile[(lc + j) * 65 + lk] = v[j];
        __syncthreads();
        const float* tr = tile + lk * 65 + lc;
        u32x4 w; w.x = cvt_pk_bf16(tr[0], tr[1]); w.y = cvt_pk_bf16(tr[2], tr[3]); w.z = cvt_pk_bf16(tr[4], tr[5]); w.w = cvt_pk_bf16(tr[6], tr[7]);
        *(u32x4*)(out + (size_t)(n0 + lk) * K + k0 + lc) = w;
        __syncthreads();
    }
}
__device__ __forceinline__ void rowprep(const float* __restrict__ x, bf16_t* __restrict__ xb, float* __restrict__ rrow, int gwave, int nwaves, int lane) {
    for (int row = gwave; row < NTOK; row += nwaves) {
        const float* xr = x + (size_t)row * DM; float ss = 0.f; f32x4 v[4];
#pragma unroll
        for (int i = 0; i < 4; ++i) { v[i] = *(const f32x4*)(xr + 4 * lane + 256 * i); const f32x4 q = v[i] * v[i]; ss += (q[0] + q[1]) + (q[2] + q[3]); }
#pragma unroll
        for (int o = 1; o < 64; o <<= 1) ss += __shfl_xor(ss, o);
        const float rn = 1.0f / sqrtf(ss * (1.0f / DM) + EPS);
#pragma unroll
        for (int i = 0; i < 4; ++i) { u32x2 w; w.x = cvt_pk_bf16(v[i][0] * rn, v[i][1] * rn); w.y = cvt_pk_bf16(v[i][2] * rn, v[i][3] * rn); *(u32x2*)(xb + (size_t)row * DM + 4 * lane + 256 * i) = w; }
    }
}
__device__ __forceinline__ void final_norm(float* __restrict__ x, const float* __restrict__ fw, int gwave, int nwaves, int lane) {
    for (int row = gwave; row < NTOK; row += nwaves) {
        float* xr = x + (size_t)row * DM; float ss = 0.f; f32x4 v[4];
#pragma unroll
        for (int i = 0; i < 4; ++i) { v[i] = *(const f32x4*)(xr + 4 * lane + 256 * i); const f32x4 q = v[i] * v[i]; ss += (q[0] + q[1]) + (q[2] + q[3]); }
#pragma unroll
        for (int o = 1; o < 64; o <<= 1) ss += __shfl_xor(ss, o);
        const float r = 1.0f / sqrtf(ss * (1.0f / DM) + EPS);
#pragma unroll
        for (int i = 0; i < 4; ++i) { const f32x4 w = *(const f32x4*)(fw + 4 * lane + 256 * i); __builtin_nontemporal_store(v[i] * r * w, (f32x4*)(xr + 4 * lane + 256 * i)); }
    }
}

#define XB_TMO      128
#define XB_XCNT(j)  (256  + 64 * (j))
#define XB_XSUB(j)  (1280 + 64 * (j))
#define XB_XGEN(j)  (2304 + 64 * (j))
#define XB_TOP      3328
#define XB_TOPGEN   3392
#define XCD_BAR_WORDS 3456
#define XB_SPIN_CAP (1u << 18)
__device__ __forceinline__ unsigned xb_ld(unsigned* p)              { return __hip_atomic_load(p, __ATOMIC_RELAXED, __HIP_MEMORY_SCOPE_AGENT); }
__device__ __forceinline__ unsigned xb_add(unsigned* p, unsigned v) { return __hip_atomic_fetch_add(p, v, __ATOMIC_RELAXED, __HIP_MEMORY_SCOPE_AGENT); }
__device__ __forceinline__ unsigned xb_xcc_id() { return (unsigned)__builtin_amdgcn_s_getreg((3 << 11) | 20) & 0xFu; }
#define XB_SPIN(cond, bar) do { unsigned _sp = 0; while (cond) { \
    if ((++_sp & 255u) == 0u) { if (xb_ld(&(bar)[XB_TMO])) break; if (_sp > XB_SPIN_CAP) { atomicAdd(&(bar)[XB_TMO], 1u); break; } } } } while (0)
struct XcdBarrier { unsigned* bar; unsigned x; volatile LAS unsigned* st; };
__device__ __forceinline__ void xcd_barrier_post(unsigned* bar) { if (threadIdx.x == 0) (void)xb_add(&bar[XB_XCNT(xb_xcc_id())], 1u); }
__device__ __forceinline__ void xcd_barrier_complete(unsigned* bar, unsigned x, unsigned& nloc, unsigned& nx) {
    const unsigned G = gridDim.x * gridDim.y * gridDim.z;
    unsigned sum, cnt, mine, sp = 0u;
    for (;;) {
        sum = 0u; cnt = 0u; mine = 0u;
#pragma unroll
        for (unsigned j = 0; j < 16; ++j) { const unsigned c = xb_ld(&bar[XB_XCNT(j)]); sum += c; cnt += (c > 0u) ? 1u : 0u; mine = (j == x) ? c : mine; }
        if (sum == G) break;
        __builtin_amdgcn_s_sleep(1);
        if ((++sp & 255u) == 0u) { if (xb_ld(&bar[XB_TMO])) break; if (sp > XB_SPIN_CAP) { atomicAdd(&bar[XB_TMO], 1u); break; } }
    }
    nloc = mine > 0u ? mine : 1u; nx = cnt > 0u ? cnt : 1u;
}
__device__ __forceinline__ void xcd_barrier(const XcdBarrier& b) {
    asm volatile("s_waitcnt vmcnt(0)" ::: "memory");
    __syncthreads();
    if (threadIdx.x == 0) {
        unsigned* bar = b.bar;
        __builtin_amdgcn_s_waitcnt(0);
        unsigned nloc = b.st[0], nx = b.st[1];
        if (nloc == 0u) { xcd_barrier_complete(bar, b.x, nloc, nx); b.st[0] = nloc; b.st[1] = nx; }
        const unsigned old = xb_add(&bar[XB_XSUB(b.x)], 1u);
        const unsigned gen = old / nloc;
        if (old + 1u == (gen + 1u) * nloc) {
            __builtin_amdgcn_fence(__ATOMIC_RELEASE, "agent");
            asm volatile("s_waitcnt vmcnt(0)" ::: "memory");
            const unsigned og = xb_add(&bar[XB_TOP], 1u);
            const unsigned tg = og / nx;
            if (og + 1u == (tg + 1u) * nx) xb_add(&bar[XB_TOPGEN], 1u);
            else XB_SPIN(xb_ld(&bar[XB_TOPGEN]) == tg, bar);
            __builtin_amdgcn_fence(__ATOMIC_ACQUIRE, "agent");
            xb_add(&bar[XB_XGEN(b.x)], 1u);
            asm volatile("s_waitcnt vmcnt(0)" ::: "memory");
        } else {
            XB_SPIN(xb_ld(&bar[XB_XGEN(b.x)]) == gen, bar);
            __builtin_amdgcn_fence(__ATOMIC_ACQUIRE, "agent");
            asm volatile("s_waitcnt vmcnt(0)" ::: "memory");
        }
    }
    __syncthreads();
}

constexpr int ATT_LDS = 3 * att::SHM_V + 3 * att::SHM_K + 8 * 64 * 4;
constexpr int LDS_MAIN = (2 * hg::GROUP_BYTES > pg8::STAGE_BYTES ? 2 * hg::GROUP_BYTES : pg8::STAGE_BYTES);
constexpr int LDS_BYTES = LDS_MAIN + 16;
constexpr size_t WS_BAR = WS_END + 1024, WS_END2 = WS_BAR + XCD_BAR_WORDS * 4;
static_assert(ATT_LDS <= LDS_MAIN, "lds");
#ifndef PH_MASK
#define PH_MASK 31
#endif
#ifndef ATT_UA
#define ATT_UA 12
#endif
constexpr int UA = ATT_UA, UB = 16 - ATT_UA;

__global__ void __launch_bounds__(NTHREADS, 2) fwd_megakernel(Params p) {
    extern __shared__ __attribute__((aligned(16))) unsigned char lds[];
    cg::grid_group grid = cg::this_grid();
    typedef const __attribute__((address_space(4))) Params* KPtr;
    const int G = gridDim.x, c = blockIdx.x;
    volatile LAS unsigned* st = (volatile LAS unsigned*)((LAS unsigned char*)lds + LDS_MAIN);
    if (threadIdx.x < 2) st[threadIdx.x] = 0u;
    { const long gt0 = (long)blockIdx.x * NTHREADS + threadIdx.x; if (gt0 < XCD_BAR_WORDS) __hip_atomic_store((unsigned*)(((KPtr)__builtin_amdgcn_kernarg_segment_ptr())->ws + WS_BAR) + gt0, 0u, __ATOMIC_RELAXED, __HIP_MEMORY_SCOPE_AGENT); }
    __syncthreads();
#define GSYNC() do { XcdBarrier b_; b_.bar = (unsigned*)(KP()->ws + WS_BAR); b_.x = xb_xcc_id(); b_.st = st; xcd_barrier(b_); } while (0)
#define IDS() int tid_ = threadIdx.x; asm volatile("" : "+v"(tid_)); const int lane = tid_ & 63; const long gtid = (long)blockIdx.x * NTHREADS + tid_, gthreads = (long)gridDim.x * NTHREADS; const int gwave = (int)(gtid >> 6), nwaves = (int)(gthreads >> 6); (void)lane; (void)gwave; (void)nwaves;
#define KP() ({ const unsigned long long _a = (unsigned long long)__builtin_amdgcn_kernarg_segment_ptr(); unsigned _lo = __builtin_amdgcn_readfirstlane((unsigned)_a), _hi = __builtin_amdgcn_readfirstlane((unsigned)(_a >> 32)); asm volatile("" : "+s"(_lo), "+s"(_hi)); (KPtr)(((unsigned long long)_hi << 32) | _lo); })
#define WSP(kp, off) ((kp)->ws + (off))
#ifdef PROBE_DUR
#define STAMP(k) do { if ((blockIdx.x == 0 || blockIdx.x == 128) && threadIdx.x == 0) { const unsigned long long now_ = __builtin_amdgcn_s_memrealtime(); \
        unsigned long long* T_ = (unsigned long long*)(KP()->ws + WS_END) + (blockIdx.x ? 16 : 0); T_[k] += now_ - T_[15]; T_[15] = now_; } } while (0)
    if ((blockIdx.x == 0 || blockIdx.x == 128) && threadIdx.x == 0) { unsigned long long* T_ = (unsigned long long*)(KP()->ws + WS_END) + (blockIdx.x ? 16 : 0);
        for (int i_ = 0; i_ < 15; ++i_) T_[i_] = 0; T_[15] = __builtin_amdgcn_s_memrealtime(); }
#else
#define STAMP(k) do { } while (0)
#endif
    { IDS();
    for (int l = 0; l < DEPTH; ++l) {
        KPtr kp = KP();
        transpose_w(kp->w_in + (size_t)l * DM * NIN, DM, NIN, (bf16_t*)WSP(kp, WS_WIN) + (size_t)l * NIN * DM, kp->norm_w + l * DM, true, (float*)lds);
        transpose_w(kp->w_ba + (size_t)l * DM * DM, DM, DM, (bf16_t*)WSP(kp, WS_WA) + (size_t)l * DM * DM, nullptr, false, (float*)lds);
        transpose_w(kp->w_bh + (size_t)l * DM * DM, DM, DM, (bf16_t*)WSP(kp, WS_WH) + (size_t)l * DM * DM, nullptr, false, (float*)lds);
        transpose_w(kp->w_out + (size_t)l * DM * DM, DM, DM, (bf16_t*)WSP(kp, WS_WO) + (size_t)l * DM * DM, nullptr, false, (float*)lds);
    }
    { KPtr kp = KP(); float* TAB = (float*)WSP(kp, WS_TAB);
    if (gtid < 1536) {
        const int pos = (int)(gtid >> 4), i = (int)(gtid & 15);
        const float inv = powf(10000.0f, -(float)i / 16.0f);
        if (pos < 32) { const float a = (float)pos * inv; TAB[TAB_COSR + pos * 16 + i] = cosf(a); TAB[TAB_SINR + pos * 16 + i] = sinf(a); }
        else { const int pc = pos - 32; const float a = (float)pc * inv; TAB[TAB_COSC + pc * 16 + i] = cosf(a); TAB[TAB_SINC + pc * 16 + i] = sinf(a); }
    }
    if (gtid >= 4096 && gtid < 4096 + DEPTH) {
        const int l = (int)(gtid - 4096); float mq = 0.f, mk = 0.f;
        for (int i = 0; i < 64; ++i) { mq = fmaxf(mq, fabsf(kp->q_norm_w[l * 64 + i])); mk = fmaxf(mk, fabsf(kp->k_norm_w[l * 64 + i])); }
        TAB[TAB_M2 + l] = 0.18033688011112042f * 64.0f * mq * mk;
    }
    if (gtid >= 2048 && gtid < 2048 + 2048) {
        const int d = (int)((gtid - 2048) >> 10), k = (int)((gtid - 2048) & 1023);
        const float a0 = kp->lbnd[(size_t)(d * DEPTH + 0) * 1024 + k], a1 = kp->lbnd[(size_t)(d * DEPTH + 1) * 1024 + k];
        const float m = fmaxf(a0, a1), e0 = expf(a0 - m), e1 = expf(a1 - m);
        TAB[TAB_LB + (d * 2 + 0) * 1024 + k] = 0.0f; TAB[TAB_LB + (d * 2 + 1) * 1024 + k] = e1 / (e0 + e1);
    }
    rowprep(kp->x, (bf16_t*)WSP(kp, WS_XB), (float*)WSP(kp, WS_RROW), gwave, nwaves, lane); } }
    grid.sync(); xcd_barrier_post((unsigned*)(KP()->ws + WS_BAR)); STAMP(0);

    for (int layer = 0; layer < DEPTH; ++layer) {
        for (int half = 0; half < 2; ++half) {
            const size_t tok0 = (size_t)half * TH;
#if PH_MASK & 1
            {
                KPtr kp = KP();
                pg8::Gemm g{(const bf16_t*)WSP(kp, WS_XB) + tok0 * DM, (const bf16_t*)WSP(kp, WS_WIN) + (size_t)layer * NIN * DM, nullptr, nullptr, TH, NIN, DM};
                pg8::StaticOrder S; S.init(TH, NIN, G, c);
                EpiProj E{(bf16_t*)WSP(kp, WS_PROJ), (const float*)WSP(kp, WS_RROW) + tok0, (const float*)WSP(kp, WS_TAB), kp->q_norm_w + layer * 64, kp->k_norm_w + layer * 64, half ? 8 : 6};
                pg8::gemm_phase<EpiProj, pg8::StaticOrder>((LAS unsigned char*)lds, g, S, E);
            }
#endif
            GSYNC(); STAMP(1);
            {
                KPtr kp = KP();
                bf16_t* PROJ = (bf16_t*)WSP(kp, WS_PROJ); const float* TAB = (const float*)WSP(kp, WS_TAB);
                const int xcd = c & 7, j = c >> 3;
                const bool light = c < 128;
#if PH_MASK & 2
                if (light) hg::hgrn_item((char*)lds, PROJ, c >> 3, c & 7, TAB + TAB_LB + (0 * 2 + layer) * 1024, TAB + TAB_LB + (1 * 2 + layer) * 1024, kp->hnorm_w + layer * 128);
#endif
                __syncthreads(); STAMP(2);
                const int nun = light ? UB : UA, ubase = light ? 16 * UA + j : (j - 16);
#if PH_MASK & 4
                for (int i = 0; i < nun; ++i) {
                    const int u = ubase + 16 * i, grp = xcd * 8 + (u >> 5), w = u & 31;
                    const int bl = grp >> 2, kvh = grp & 3, head = kvh * 4 + (w & 3), qb = w >> 2;
                    const size_t r0 = (size_t)bl * SEQ;
                    att::attn_unit(PROJ + PO_Q + (r0 + qb * 256) * 1024 + head * 64, PROJ + PO_K + r0 * 256 + kvh * 64, PROJ + PO_V + r0 * 256 + kvh * 64,
                                   PROJ + PO_AG + (r0 + qb * 256) * 1024 + head * 64, TAB[TAB_M2 + layer], (char*)lds);
                }
#endif
                STAMP(3);
            }
            GSYNC(); STAMP(4);
#if PH_MASK & 8
            {
                KPtr kp = KP(); bf16_t* PROJ = (bf16_t*)WSP(kp, WS_PROJ);
                pg8::Gemm g{PROJ + PO_Q, (const bf16_t*)WSP(kp, WS_WA) + (size_t)layer * DM * DM, PROJ + PO_HQ, (const bf16_t*)WSP(kp, WS_WH) + (size_t)layer * DM * DM, TH, DM, DM};
                pg8::TwoPassOrder S; S.S.init(TH, DM, G, c);
                EpiMerge E{PROJ + (half ? PO_MA1 : PO_MA), PROJ + PO_MH};
                pg8::gemm_phase<EpiMerge, pg8::TwoPassOrder>((LAS unsigned char*)lds, g, S, E);
            }
#endif
            GSYNC(); STAMP(5);
#if PH_MASK & 16
            {
                KPtr kp = KP(); bf16_t* PROJ = (bf16_t*)WSP(kp, WS_PROJ);
                pg8::Gemm g{PROJ + (half ? PO_MA1 : PO_MA), (const bf16_t*)WSP(kp, WS_WO) + (size_t)layer * DM * DM, nullptr, nullptr, TH, DM, DM};
                pg8::StaticOrder S; S.init(TH, DM, G, c);
                EpiResid E{(layer == 0 ? kp->x : (const float*)kp->out) + tok0 * DM, kp->out + tok0 * DM};
                pg8::gemm_phase<EpiResid, pg8::StaticOrder>((LAS unsigned char*)lds, g, S, E);
            }
#endif
            if (half == 1) GSYNC();
            STAMP(6);
        }
        if (layer + 1 < DEPTH) { IDS(); KPtr kp = KP(); rowprep(kp->out, (bf16_t*)WSP(kp, WS_XB), (float*)WSP(kp, WS_RROW), gwave, nwaves, lane); GSYNC(); STAMP(7); }
    }
    { IDS(); KPtr kp = KP(); final_norm(kp->out, kp->fnorm_w, gwave, nwaves, lane); }
#ifdef PROBE_DUR
    GSYNC(); STAMP(8);
    if (blockIdx.x == 0) {
        const unsigned long long* T_ = (const unsigned long long*)(KP()->ws + WS_END);
        const unsigned long long dt = T_[PROBE_DUR], nn = T_[PROBE_RVR] / 100;
        float* o_ = KP()->out;
        for (unsigned long long i_ = threadIdx.x; i_ < nn; i_ += NTHREADS) o_[i_ * 64] += 0.1f;
        const unsigned long long t0_ = __builtin_amdgcn_s_memrealtime();
        while (__builtin_amdgcn_s_memrealtime() - t0_ < dt) __builtin_amdgcn_s_sleep(8);
    }
#endif
}

extern "C" void kernel_launch(void* const* d_in, const int* in_sizes, int n_in, void* d_out, int out_size, void* d_ws, size_t ws_size, hipStream_t stream) {
    static int grid_blocks = 0;
    if (grid_blocks == 0) {
        if (n_in != 11 || in_sizes[0] != NTOK * DM || out_size != NTOK * DM || ws_size < WS_END2) {
            fprintf(stderr, "kernel_launch: shape mismatch (n_in %d, in0 %d, out %d, ws %zu, need %zu)\n", n_in, n_in > 0 ? in_sizes[0] : -1, out_size, ws_size, (size_t)WS_END); grid_blocks = -1; return; }
        int dev = 0, cus = 0, per_cu = 0;
        hipGetDevice(&dev); hipDeviceGetAttribute(&cus, hipDeviceAttributeMultiprocessorCount, dev);
        if (hipFuncSetAttribute((const void*)fwd_megakernel, hipFuncAttributeMaxDynamicSharedMemorySize, LDS_BYTES) != hipSuccess) { fprintf(stderr, "kernel_launch: hipFuncSetAttribute failed\n"); grid_blocks = -1; return; }
        hipOccupancyMaxActiveBlocksPerMultiprocessor(&per_cu, (const void*)fwd_megakernel, NTHREADS, LDS_BYTES);
        if (per_cu < 1) { fprintf(stderr, "kernel_launch: occupancy query says %d\n", per_cu); per_cu = 1; }
        (void)hipGetLastError();
        grid_blocks = cus;
    }
    if (grid_blocks < 0) return;
    Params p{};
    p.x = (const float*)d_in[0]; p.w_in = (const float*)d_in[1]; p.norm_w = (const float*)d_in[2]; p.q_norm_w = (const float*)d_in[3]; p.k_norm_w = (const float*)d_in[4];
    p.lbnd = (const float*)d_in[5]; p.hnorm_w = (const float*)d_in[6]; p.w_ba = (const float*)d_in[7]; p.w_bh = (const float*)d_in[8]; p.w_out = (const float*)d_in[9];
    p.fnorm_w = (const float*)d_in[10]; p.out = (float*)d_out; p.ws = (unsigned char*)d_ws;
    void* args[] = {&p};
    hipError_t e = hipLaunchCooperativeKernel((const void*)fwd_megakernel, dim3(grid_blocks), dim3(NTHREADS), args, LDS_BYTES, stream);
    if (e != hipSuccess) fprintf(stderr, "cooperative launch failed: %s (grid %d)\n", hipGetErrorString(e), grid_blocks);
}
```
